# Optimizing an MI355X kernel written in HIP

```python
import jax, jax.numpy as jnp
from jax import lax
import numpy as np

D_MODEL = 4096
BATCH = 2
SEQ = 8192
DEPTH = 1

CHUNK = 64
D_FF = ((8 * D_MODEL // 3 + 127) // 128) * 128
MACARON_WEIGHT = 0.5
NORM_EPS = 1e-6

D_HGRN = D_MODEL // 2
HGRN_EXPAND = 128
HGRN_HEADS = D_HGRN // HGRN_EXPAND
HGRN_DK = HGRN_EXPAND
HGRN_DV = D_HGRN // HGRN_HEADS

D_ATTN = D_MODEL // 2
ATTN_HEADS = 16
ATTN_HEAD_DIM = D_ATTN // ATTN_HEADS
LEFT_CHUNKS = 8
BAND = (LEFT_CHUNKS + 1) * CHUNK
MAX_REL = 256

IN_SIZES = (D_HGRN, D_HGRN, D_HGRN, D_HGRN, D_ATTN, D_ATTN, D_ATTN, D_MODEL, D_MODEL)
IN_COLS = int(sum(IN_SIZES))
IN_SPLITS = tuple(int(s) for s in np.cumsum(IN_SIZES)[:-1])

kernel_name = "hybrid_hgrn2_chunkattn_macaron_sandwich"


def rmsnorm(x, g):
    xf = x.astype(jnp.float32)
    y = xf * lax.rsqrt(jnp.mean(xf * xf, axis=-1, keepdims=True) + NORM_EPS)
    return (y * g.astype(jnp.float32)).astype(x.dtype)


def swiglu_half_step(x, pre_g, post_g, w1, w3, w2):
    h = rmsnorm(x, pre_g)
    y = (jax.nn.silu(h @ w1) * (h @ w3)) @ w2
    return x + MACARON_WEIGHT * rmsnorm(y, post_g)


def hgrn2_mixer(q_raw, f_raw, i_raw, g_raw, lb, norm_g):
    B, S, _ = q_raw.shape
    nc = S // CHUNK
    dtype = q_raw.dtype

    def to_chunks(t, d):
        return t.reshape(B, nc, CHUNK, HGRN_HEADS, d).transpose(1, 0, 3, 2, 4).astype(jnp.float32)

    f = lb + (1.0 - lb) * jax.nn.sigmoid(f_raw.astype(jnp.float32))
    q = to_chunks(jax.nn.silu(q_raw.astype(jnp.float32)), HGRN_DK)
    k = to_chunks(1.0 - f, HGRN_DK)
    logf = to_chunks(jnp.log(f), HGRN_DK)
    v = to_chunks(i_raw, HGRN_DV)
    tri = jnp.tril(jnp.ones((CHUNK, CHUNK), dtype=bool))[:, :, None]

    def step(state, xs):
        qc, kc, vc, lfc = xs
        a = jnp.cumsum(lfc, axis=2)
        diff = a[:, :, :, None, :] - a[:, :, None, :, :]
        decay = jnp.exp(jnp.where(tri, diff, -jnp.inf))
        scores = jnp.einsum('bhtsk,bhsk->bhts', decay * qc[:, :, :, None, :], kc)
        o = jnp.einsum('bhts,bhsv->bhtv', scores, vc)
        o = o + jnp.einsum('bhtk,bhkv->bhtv', qc * jnp.exp(a), state)
        a_last = a[:, :, -1:, :]
        new_state = jnp.exp(a_last[:, :, 0, :])[..., None] * state + jnp.einsum(
            'bhsk,bhsv->bhkv', kc * jnp.exp(a_last - a), vc)
        return new_state, o

    s0 = jnp.zeros((B, HGRN_HEADS, HGRN_DK, HGRN_DV), jnp.float32)
    _, o = lax.scan(step, s0, (q, k, v, logf))
    o = o.transpose(1, 0, 3, 2, 4).reshape(B, S, HGRN_HEADS, HGRN_DV)
    o = o * lax.rsqrt(jnp.mean(o * o, axis=-1, keepdims=True) + NORM_EPS)
    o = o * norm_g.astype(jnp.float32).reshape(HGRN_HEADS, HGRN_DV)
    o = o.reshape(B, S, D_HGRN) * jax.nn.silu(g_raw.astype(jnp.float32))
    return o.astype(dtype)


def chunk_band_attention(q_raw, k_raw, v_raw, rel_bias):
    B, S, _ = q_raw.shape
    nc = S // CHUNK
    pad = LEFT_CHUNKS * CHUNK

    def heads(t):
        return t.reshape(B, S, ATTN_HEADS, ATTN_HEAD_DIM).transpose(0, 2, 1, 3)

    q = heads(q_raw) * (ATTN_HEAD_DIM ** -0.5)
    k = jnp.pad(heads(k_raw), ((0, 0), (0, 0), (pad, 0), (0, 0)))
    v = jnp.pad(heads(v_raw), ((0, 0), (0, 0), (pad, 0), (0, 0)))
    q_chunks = q.reshape(B, ATTN_HEADS, nc, CHUNK, ATTN_HEAD_DIM).transpose(2, 0, 1, 3, 4)

    qi = jnp.arange(CHUNK)[:, None]
    kj = jnp.arange(BAND)[None, :]
    rel = qi - kj + pad
    bias = rel_bias.astype(jnp.float32)[:, jnp.clip(rel, -MAX_REL, MAX_REL) + MAX_REL]

    def one_chunk(args):
        c, q_blk = args
        start = c * CHUNK
        k_band = lax.dynamic_slice_in_dim(k, start, BAND, axis=2)
        v_band = lax.dynamic_slice_in_dim(v, start, BAND, axis=2)
        s = jnp.einsum('bhqd,bhkd->bhqk', q_blk, k_band).astype(jnp.float32) + bias
        s = jnp.where(kj >= pad - start, s, -jnp.inf)
        p = jax.nn.softmax(s, axis=-1).astype(v_band.dtype)
        return jnp.einsum('bhqk,bhkd->bhqd', p, v_band)

    out = lax.map(one_chunk, (jnp.arange(nc, dtype=jnp.int32), q_chunks))
    return out.transpose(1, 0, 3, 2, 4).reshape(B, S, D_ATTN)


def setup_inputs(seed: int = 0) -> dict:
    key = jax.random.key(seed)
    ks = jax.random.split(key, 20)
    f32 = jnp.float32

    def w(k, shape, fan_in):
        return jax.random.normal(k, shape, f32) * (fan_in ** -0.5)

    def gain(k, shape):
        return 1.0 + 0.1 * jax.random.normal(k, shape, f32)

    return {
        "x": jax.random.normal(ks[0], (BATCH, SEQ, D_MODEL), f32),
        "ffn1_pre_g": gain(ks[1], (DEPTH, D_MODEL)),
        "ffn1_post_g": gain(ks[2], (DEPTH, D_MODEL)),
        "ffn1_w1": w(ks[3], (DEPTH, D_MODEL, D_FF), D_MODEL),
        "ffn1_w3": w(ks[4], (DEPTH, D_MODEL, D_FF), D_MODEL),
        "ffn1_w2": w(ks[5], (DEPTH, D_FF, D_MODEL), D_FF),
        "mix_pre_g": gain(ks[6], (DEPTH, D_MODEL)),
        "mix_post_g": gain(ks[7], (DEPTH, D_MODEL)),
        "w_in": w(ks[8], (DEPTH, D_MODEL, IN_COLS), D_MODEL),
        "b_gate": 0.1 * jax.random.normal(ks[9], (DEPTH, 2, D_MODEL), f32),
        "hgrn_lb_logits": 0.5 * jax.random.normal(ks[10], (DEPTH + 1, D_HGRN), f32),
        "hgrn_norm_g": gain(ks[11], (DEPTH, D_HGRN)),
        "rel_bias": 0.2 * jax.random.normal(ks[12], (DEPTH, ATTN_HEADS, 2 * MAX_REL + 1), f32),
        "w_up_a": w(ks[13], (DEPTH, D_HGRN, D_MODEL), D_HGRN),
        "w_up_b": w(ks[14], (DEPTH, D_ATTN, D_MODEL), D_ATTN),
        "w_out": w(ks[15], (DEPTH, D_MODEL, D_MODEL), D_MODEL),
        "ffn2_pre_g": gain(ks[16], (DEPTH, D_MODEL)),
        "ffn2_post_g": gain(ks[17], (DEPTH, D_MODEL)),
        "ffn2_w1": w(ks[18], (DEPTH, D_MODEL, D_FF), D_MODEL),
        "ffn2_w3": w(ks[19], (DEPTH, D_MODEL, D_FF), D_MODEL),
        "ffn2_w2": w(jax.random.fold_in(key, 99), (DEPTH, D_FF, D_MODEL), D_FF),
    }


def reference(x, ffn1_pre_g, ffn1_post_g, ffn1_w1, ffn1_w3, ffn1_w2,
              mix_pre_g, mix_post_g, w_in, b_gate, hgrn_lb_logits, hgrn_norm_g,
              rel_bias, w_up_a, w_up_b, w_out,
              ffn2_pre_g, ffn2_post_g, ffn2_w1, ffn2_w3, ffn2_w2):
    lower_bounds = jnp.cumsum(jax.nn.softmax(hgrn_lb_logits.astype(jnp.float32), axis=0), axis=0)
    for layer in range(DEPTH):
        x = swiglu_half_step(x, ffn1_pre_g[layer], ffn1_post_g[layer],
                             ffn1_w1[layer], ffn1_w3[layer], ffn1_w2[layer])
        h = rmsnorm(x, mix_pre_g[layer])
        proj = h @ w_in[layer]
        qa, fa, ia, ga, qb, kb, vb, gate_a, gate_b = jnp.split(proj, IN_SPLITS, axis=-1)
        y_a = hgrn2_mixer(qa, fa, ia, ga, lower_bounds[layer], hgrn_norm_g[layer]) @ w_up_a[layer]
        y_b = chunk_band_attention(qb, kb, vb, rel_bias[layer]) @ w_up_b[layer]
        g_a = jax.nn.sigmoid(gate_a + b_gate[layer, 0])
        g_b = jax.nn.sigmoid(gate_b + b_gate[layer, 1])
        y = (g_a * y_a + g_b * y_b) @ w_out[layer]
        x = x + rmsnorm(y, mix_post_g[layer])
        x = swiglu_half_step(x, ffn2_pre_g[layer], ffn2_post_g[layer],
                             ffn2_w1[layer], ffn2_w3[layer], ffn2_w2[layer])
    return x
```

```cpp
#include <hip/hip_runtime.h>
#include <cstdio>
#include <cstdint>
__device__ __forceinline__ int lane_now() { unsigned m = ~0u; asm volatile("" : "+s"(m)); return (int)__builtin_amdgcn_mbcnt_hi(m, __builtin_amdgcn_mbcnt_lo(m, 0u)); }
__device__ __forceinline__ void wht8(float (&v)[8]) {
#pragma unroll
    for (int h = 1; h < 8; h <<= 1)
#pragma unroll
        for (int i = 0; i < 8; i += 2 * h)
#pragma unroll
            for (int j = i; j < i + h; ++j) { const float a = v[j], b = v[j + h]; v[j] = a + b; v[j + h] = a - b; }
}
__device__ __forceinline__ void wht_x(float (&v)[8], int mask, int lane) {
    const float sg = (lane & mask) ? -1.0f : 1.0f;
#pragma unroll
    for (int i = 0; i < 8; ++i) { const float p = __shfl_xor(v[i], mask); v[i] = __builtin_fmaf(v[i], sg, p); }
}
template <int CTRL>
__device__ __forceinline__ float dpp_f(float x) { return __builtin_bit_cast(float, __builtin_amdgcn_update_dpp(0, __builtin_bit_cast(int, x), CTRL, 0xF, 0xF, true)); }
template <int CTRL>
__device__ __forceinline__ void wht_q(float (&v)[8], int mask, int lane) {
    const float sg = (lane & mask) ? -1.0f : 1.0f;
#pragma unroll
    for (int i = 0; i < 8; ++i) { const float p = dpp_f<CTRL>(v[i]); v[i] = __builtin_fmaf(v[i], sg, p); }
}
constexpr int NQ8S = 1;
__host__ __device__ constexpr int q8_seg(int s) { return NQ8S == 1 ? 1 : (s == 0 ? 1 : s == 1 ? 2 : 6); }
__host__ __device__ constexpr int bf_seg(int s) { return NQ8S == 1 ? (s == 0 ? 0 : s + 1) : (s == 0 ? 0 : s == 1 ? 3 : s == 2 ? 4 : 5); }
constexpr bool DQ1 = true, DQ2 = true;
constexpr int TAILNB = 80;
constexpr bool TAILW2 = DQ2;
namespace pg8 {
#define PG8_LAS __attribute__((address_space(3)))
typedef unsigned short bf16_t;
typedef short bf16x8 __attribute__((ext_vector_type(8)));
typedef float f32x4 __attribute__((ext_vector_type(4)));
typedef unsigned u32x4 __attribute__((ext_vector_type(4)));
typedef unsigned u32x2 __attribute__((ext_vector_type(2)));
constexpr int BM = 256, BK = 64, HALF = 128, HTB = HALF * BK * 2  , STAGE_BYTES = 8 * HTB, NXCD = 8, WGM = 4;

__host__ __device__ __forceinline__ int lds_byte(int r, int c) { const int st = (r >> 4) * 2 + (c >> 5), rr = r & 15, cc = c & 31, ob = rr * 64 + cc * 2; return st * 1024 + (ob ^ (((ob >> 9) & 1) << 5)); }
__host__ __device__ __forceinline__ void stage_rc(int b, int& R, int& C) { const int st = b / 1024, sb = b % 1024, swz = sb ^ (((sb >> 9) & 1) << 5); R = (st >> 1) * 16 + swz / 64; C = (st & 1) * 32 + (swz % 64) / 2; }
__host__ __device__ __forceinline__ int perm32(int rho) { const int n = rho >> 4, i = rho & 15; return 8 * (i >> 2) + 4 * n + (i & 3); }

struct Unit { int pm, pn; };
struct Gemm { const bf16_t* A; const bf16_t* Bt; int M, N, K; };

struct StaticOrder {
    int nM, nN, nwg, G, c, wv;
    __host__ __device__ void init(int M, int N, int G_, int c_) { nM = M / BM; nN = N / BM; nwg = nM * nN; G = G_; c = c_; }
    __host__ __device__ bool next(int i, Unit& u) const {
        const long L = (long)i * G + c; if (L >= nwg) return false;
        int wgid = (int)L; { const int q = nwg / NXCD, r = nwg % NXCD, xcd = wgid % NXCD, off = wgid / NXCD; wgid = (xcd < r ? xcd * (q + 1) : r * (q + 1) + (xcd - r) * q) + off; }
        const int nig = WGM * nN, gid = wgid / nig, fm = gid * WGM, gsz = (nM - fm) < WGM ? (nM - fm) : WGM;
        u.pm = fm + ((wgid % nig) % gsz); u.pn = (wgid % nig) / gsz; return true;
    }
    __device__ __forceinline__ void a_ready(const Unit&) const {}
    __device__ __forceinline__ void done(const Unit&) const {}
};

typedef float f32x2c_t __attribute__((ext_vector_type(2))); typedef __bf16 bf16x2c_t __attribute__((ext_vector_type(2)));
__device__ __forceinline__ unsigned cvt_pk_bf16(float lo, float hi) { f32x2c_t v = {lo, hi}; bf16x2c_t b = __builtin_convertvector(v, bf16x2c_t); return __builtin_bit_cast(unsigned, b); }
typedef unsigned u32x2_t __attribute__((ext_vector_type(2)));
__device__ __forceinline__ unsigned pk4_g8(float a, float b, float c, float d) {
    const float MG = 12582912.0f;
    const unsigned ua = __builtin_bit_cast(unsigned, fmaxf(a * 255.0f, 1.0f) + MG), ub = __builtin_bit_cast(unsigned, fmaxf(b * 255.0f, 1.0f) + MG);
    const unsigned uc = __builtin_bit_cast(unsigned, fmaxf(c * 255.0f, 1.0f) + MG), ud = __builtin_bit_cast(unsigned, fmaxf(d * 255.0f, 1.0f) + MG);
    return __builtin_amdgcn_perm(ub, ua, 0x0c0c0400u) | (__builtin_amdgcn_perm(ud, uc, 0x0c0c0400u) << 16);
}
#define G8F(u, i) ((float)(((u) >> (8 * (i))) & 0xffu))
__device__ __forceinline__ float sigm(float x) { return __builtin_amdgcn_rcpf(1.0f + __expf(-x)); }
__device__ __forceinline__ float siluf(float x) { return x * sigm(x); }
__device__ __forceinline__ float bflo(unsigned u) { return __uint_as_float(u << 16); }
__device__ __forceinline__ float bfhi(unsigned u) { return __uint_as_float(u & 0xffff0000u); }

struct EpiSwiglu {
    static constexpr bool PERM = true, AFTER_DRAIN = false; static constexpr int MID_T = -1;
    bf16_t* O; int ldc;
    __device__ __forceinline__ void operator()(const f32x4 (&acc)[2][2][4][2], const Unit& u, int wr, int wc, int fr, int fq) const {
        const int row0 = u.pm * BM + wr * 64 + fr, col0 = u.pn * HALF + wc * 32 + 8 * fq;
#pragma unroll
        for (int ai = 0; ai < 2; ++ai)
#pragma unroll
            for (int m = 0; m < 4; ++m) { bf16_t* rowp = O + (size_t)(row0 + ai * HALF + m * 16) * ldc + col0;
                const f32x4 a0 = acc[ai][0][m][0], a1 = acc[ai][0][m][1], b0 = acc[ai][1][m][0], b1 = acc[ai][1][m][1];
                f32x4 h0, h1;
#pragma unroll
                for (int j = 0; j < 4; ++j) { h0[j] = siluf(a0[j]) * b0[j]; h1[j] = siluf(a1[j]) * b1[j]; }
                u32x4 w; w.x = cvt_pk_bf16(h0[0], h0[1]); w.y = cvt_pk_bf16(h0[2], h0[3]); w.z = cvt_pk_bf16(h1[0], h1[1]); w.w = cvt_pk_bf16(h1[2], h1[3]);
                *(u32x4*)rowp = w; }
    }
};
struct EpiProj {
    static constexpr bool PERM = true, AFTER_DRAIN = false; static constexpr int MID_T = -1;
    bf16_t *QA, *IA, *GA, *QB, *KB, *VB; float qscale;
    __device__ __forceinline__ void operator()(const f32x4 (&acc)[2][2][4][2], const Unit& u, int wr, int wc, int fr, int fq) const {
        const int row0 = u.pm * BM + wr * 64 + fr, cw = wc * 32 + 8 * fq, pn = u.pn;
        {
            const int seg = bf_seg(pn >> 3); const int colt = (pn & 7) * 256 + cw;
            bf16_t* base = seg == 0 ? QA : seg == 2 ? IA : seg == 3 ? GA : seg == 4 ? QB : seg == 5 ? KB : VB;
            const bool do_silu = (seg == 0 || seg == 3); const float sc = (seg == 4) ? qscale : 1.0f;
#pragma unroll
            for (int ai = 0; ai < 2; ++ai)
#pragma unroll
                for (int m = 0; m < 4; ++m) { bf16_t* rowp = base + (size_t)(row0 + ai * HALF + m * 16) * 2048 + colt;
#pragma unroll
                    for (int bj = 0; bj < 2; ++bj) { f32x4 v0 = acc[ai][bj][m][0] * sc, v1 = acc[ai][bj][m][1] * sc;
                        if (do_silu) {
#pragma unroll
                            for (int j = 0; j < 4; ++j) { v0[j] = siluf(v0[j]); v1[j] = siluf(v1[j]); } }
                        u32x4 w; w.x = cvt_pk_bf16(v0[0], v0[1]); w.y = cvt_pk_bf16(v0[2], v0[3]); w.z = cvt_pk_bf16(v1[0], v1[1]); w.w = cvt_pk_bf16(v1[2], v1[3]);
                        *(u32x4*)(rowp + bj * HALF) = w; } }
        }
    }
};
__device__ __forceinline__ float i2f(float bits) { return (float)__builtin_bit_cast(int, bits); }
struct EpiGatesQ8 {
    static constexpr bool PERM = true, AFTER_DRAIN = false; static constexpr int MID_T = -1;
    bf16_t *GTA, *GTB; float* F; const float* lb; const float* bgate; const float* SA; const float* CM; bf16_t *QA, *IA, *GA, *QB, *KB, *VB; float qscale;
    __device__ __forceinline__ void operator()(const f32x4 (&acc)[2][2][4][2], const Unit& u, int wr, int wc, int fr, int fq) const {
        int row0 = u.pm * BM + wr * 64 + fr; const int cw = wc * 32 + 8 * fq, pn = u.pn;
        int qcol = pn * 256 + cw;
        asm volatile("" : "+v"(row0), "+v"(qcol));
        f32x4 cs[2][2];
#pragma unroll
        for (int bj = 0; bj < 2; ++bj)
#pragma unroll
            for (int n = 0; n < 2; ++n) cs[bj][n] = *(const f32x4*)(CM + qcol + bj * HALF + 4 * n) * (1.0f / 127.0f);
        const int seg = pn < 8 * NQ8S ? q8_seg(pn >> 3) : 7;
        if (seg != 1 && seg != 7) {
            const int colt = qcol & 2047;
            bf16_t* base = seg == 0 ? QA : seg == 2 ? IA : seg == 3 ? GA : seg == 4 ? QB : seg == 5 ? KB : VB;
            const bool do_silu = (seg == 0 || seg == 3); const float sc = (seg == 4) ? qscale : 1.0f;
#pragma unroll
            for (int ai = 0; ai < 2; ++ai)
#pragma unroll
                for (int m = 0; m < 4; ++m) { const int row = row0 + ai * HALF + m * 16; const float sa = SA[row] * sc; bf16_t* rowp = base + (size_t)row * 2048 + colt;
#pragma unroll
                    for (int bj = 0; bj < 2; ++bj) { f32x4 v0, v1;
#pragma unroll
                        for (int j = 0; j < 4; ++j) { v0[j] = i2f(acc[ai][bj][m][0][j]) * sa * cs[bj][0][j]; v1[j] = i2f(acc[ai][bj][m][1][j]) * sa * cs[bj][1][j]; }
                        if (do_silu) {
#pragma unroll
                            for (int j = 0; j < 4; ++j) { v0[j] = siluf(v0[j]); v1[j] = siluf(v1[j]); } }
                        u32x4 w; w.x = cvt_pk_bf16(v0[0], v0[1]); w.y = cvt_pk_bf16(v0[2], v0[3]); w.z = cvt_pk_bf16(v1[0], v1[1]); w.w = cvt_pk_bf16(v1[2], v1[3]);
                        *(u32x4*)(rowp + bj * HALF) = w; } }
        } else if (seg == 1) {
            const int colt = qcol & 2047;
            f32x4 lbv[2][2];
#pragma unroll
            for (int bj = 0; bj < 2; ++bj)
#pragma unroll
                for (int n = 0; n < 2; ++n) lbv[bj][n] = *(const f32x4*)(lb + colt + bj * HALF + 4 * n);
#pragma unroll
            for (int ai = 0; ai < 2; ++ai)
#pragma unroll
                for (int m = 0; m < 4; ++m) { const int row = row0 + ai * HALF + m * 16; const float sa = SA[row]; float* rowp = F + (size_t)row * 2048 + colt;
#pragma unroll
                    for (int bj = 0; bj < 2; ++bj)
#pragma unroll
                        for (int n = 0; n < 2; ++n) { f32x4 o;
#pragma unroll
                            for (int j = 0; j < 4; ++j) o[j] = lbv[bj][n][j] + (1.0f - lbv[bj][n][j]) * sigm(i2f(acc[ai][bj][m][n][j]) * sa * cs[bj][n][j]);
                            *(f32x4*)(rowp + bj * HALF + 4 * n) = o; } }
        } else {
            const int gcol = qcol - 2048 * NQ8S; const bool isB = gcol >= 4096;
            bf16_t* base = isB ? GTB : GTA; const int colt = gcol & 4095;
            f32x4 bv[2][2];
#pragma unroll
            for (int bj = 0; bj < 2; ++bj)
#pragma unroll
                for (int n = 0; n < 2; ++n) bv[bj][n] = *(const f32x4*)(bgate + gcol + bj * HALF + 4 * n);
#pragma unroll
            for (int ai = 0; ai < 2; ++ai)
#pragma unroll
                for (int m = 0; m < 4; ++m) { const int row = row0 + ai * HALF + m * 16; const float sa = SA[row]; unsigned char* rowp = (unsigned char*)base + (size_t)row * 4096 + colt;
#pragma unroll
                    for (int bj = 0; bj < 2; ++bj) { f32x4 v0, v1;
#pragma unroll
                        for (int j = 0; j < 4; ++j) { v0[j] = sigm(i2f(acc[ai][bj][m][0][j]) * sa * cs[bj][0][j] + bv[bj][0][j]); v1[j] = sigm(i2f(acc[ai][bj][m][1][j]) * sa * cs[bj][1][j] + bv[bj][1][j]); }
                        u32x2_t w; w.x = pk4_g8(v0[0], v0[1], v0[2], v0[3]); w.y = pk4_g8(v1[0], v1[1], v1[2], v1[3]);
                        *(u32x2_t*)(rowp + bj * HALF) = w; } }
        }
    }
};
template <bool HAD>
struct EpiSwigluQ8T {
    static constexpr bool PERM = true, AFTER_DRAIN = false; static constexpr int MID_T = -1;
    bf16_t* O; int ldc; const float* SA; const float* CM;
    __device__ __forceinline__ void operator()(const f32x4 (&acc)[2][2][4][2], const Unit& u, int wr, int wc, int fr, int fq) const {
        int row0 = u.pm * BM + wr * 64 + fr, cw = wc * 32 + 8 * fq;
        asm volatile("" : "+v"(row0), "+v"(cw));
        const int col0 = u.pn * HALF + cw, brow = u.pn * BM + cw;
        f32x4 cs[2][2];
#pragma unroll
        for (int bj = 0; bj < 2; ++bj)
#pragma unroll
            for (int n = 0; n < 2; ++n) cs[bj][n] = *(const f32x4*)(CM + brow + bj * HALF + 4 * n) * (1.0f / 127.0f);
        float sav[2][4];
#pragma unroll
        for (int ai = 0; ai < 2; ++ai)
#pragma unroll
            for (int m = 0; m < 4; ++m) sav[ai][m] = SA[row0 + ai * HALF + m * 16];
#pragma unroll
        for (int ai = 0; ai < 2; ++ai)
#pragma unroll
            for (int m = 0; m < 4; ++m) { const int row = row0 + ai * HALF + m * 16; const float sa = sav[ai][m]; bf16_t* rowp = O + (size_t)row * ldc + col0;
                float v[8];
#pragma unroll
                for (int j = 0; j < 4; ++j) { v[j] = siluf(i2f(acc[ai][0][m][0][j]) * sa * cs[0][0][j]) * (i2f(acc[ai][1][m][0][j]) * sa * cs[1][0][j]);
                                              v[4 + j] = siluf(i2f(acc[ai][0][m][1][j]) * sa * cs[0][1][j]) * (i2f(acc[ai][1][m][1][j]) * sa * cs[1][1][j]); }
                if constexpr (HAD) {
                    const int ln = fr + 16 * fq;
                    wht8(v); wht_x(v, 16, ln); wht_x(v, 32, ln);
                }
                u32x4 w; w.x = cvt_pk_bf16(v[0], v[1]); w.y = cvt_pk_bf16(v[2], v[3]); w.z = cvt_pk_bf16(v[4], v[5]); w.w = cvt_pk_bf16(v[6], v[7]);
                *(u32x4*)rowp = w; }
    }
};
struct EpiBf16Q8 {
    static constexpr bool PERM = true, AFTER_DRAIN = false; static constexpr int MID_T = -1;
    bf16_t* O; int ldc; const float* SA; const float* CM; float mul;
    __device__ __forceinline__ void operator()(const f32x4 (&acc)[2][2][4][2], const Unit& u, int wr, int wc, int fr, int fq) const {
        int row0 = u.pm * BM + wr * 64 + fr, col0 = u.pn * BM + wc * 32 + 8 * fq;
        asm volatile("" : "+v"(row0), "+v"(col0));
        f32x4 cs[2][2];
#pragma unroll
        for (int bj = 0; bj < 2; ++bj)
#pragma unroll
            for (int n = 0; n < 2; ++n) cs[bj][n] = *(const f32x4*)(CM + col0 + bj * HALF + 4 * n) * (mul / 127.0f);
#pragma unroll
        for (int ai = 0; ai < 2; ++ai)
#pragma unroll
            for (int m = 0; m < 4; ++m) { const int row = row0 + ai * HALF + m * 16; const float sa = SA[row]; bf16_t* rowp = O + (size_t)row * ldc + col0;
#pragma unroll
                for (int bj = 0; bj < 2; ++bj) { f32x4 v0, v1;
#pragma unroll
                    for (int j = 0; j < 4; ++j) { v0[j] = i2f(acc[ai][bj][m][0][j]) * sa * cs[bj][0][j]; v1[j] = i2f(acc[ai][bj][m][1][j]) * sa * cs[bj][1][j]; }
                    u32x4 w; w.x = cvt_pk_bf16(v0[0], v0[1]); w.y = cvt_pk_bf16(v0[2], v0[3]); w.z = cvt_pk_bf16(v1[0], v1[1]); w.w = cvt_pk_bf16(v1[2], v1[3]);
                    *(u32x4*)(rowp + bj * HALF) = w; } }
    }
};
struct EpiUpGate {
    static constexpr bool PERM = true, AFTER_DRAIN = false; static constexpr int MID_T = 32;
    bf16_t* O; const unsigned char* GA_; const unsigned char* GB_;
    __device__ __forceinline__ void mid(f32x4 (&acc)[2][2][4][2], const Unit& u, int wr, int wc, int fr, int fq) const {
        int row0 = u.pm * BM + wr * 64 + fr, col0 = u.pn * BM + wc * 32 + 8 * fq;
        asm volatile("" : "+v"(row0), "+v"(col0));
#pragma unroll
        for (int ai = 0; ai < 2; ++ai) {
            u32x2_t ga[4][2], gb[4][2];
#pragma unroll
            for (int m = 0; m < 4; ++m)
#pragma unroll
                for (int bj = 0; bj < 2; ++bj) { const size_t off = (size_t)(row0 + ai * HALF + m * 16) * 4096 + col0 + bj * HALF;
                    ga[m][bj] = *(const u32x2_t*)(GA_ + off); gb[m][bj] = *(const u32x2_t*)(GB_ + off); }
#pragma unroll
            for (int m = 0; m < 4; ++m)
#pragma unroll
                for (int bj = 0; bj < 2; ++bj) { const u32x2_t a = ga[m][bj], b = gb[m][bj];
                    acc[ai][bj][m][0][0] *= G8F(a.x, 0) * __builtin_amdgcn_rcpf(G8F(b.x, 0)); acc[ai][bj][m][0][1] *= G8F(a.x, 1) * __builtin_amdgcn_rcpf(G8F(b.x, 1));
                    acc[ai][bj][m][0][2] *= G8F(a.x, 2) * __builtin_amdgcn_rcpf(G8F(b.x, 2)); acc[ai][bj][m][0][3] *= G8F(a.x, 3) * __builtin_amdgcn_rcpf(G8F(b.x, 3));
                    acc[ai][bj][m][1][0] *= G8F(a.y, 0) * __builtin_amdgcn_rcpf(G8F(b.y, 0)); acc[ai][bj][m][1][1] *= G8F(a.y, 1) * __builtin_amdgcn_rcpf(G8F(b.y, 1));
                    acc[ai][bj][m][1][2] *= G8F(a.y, 2) * __builtin_amdgcn_rcpf(G8F(b.y, 2)); acc[ai][bj][m][1][3] *= G8F(a.y, 3) * __builtin_amdgcn_rcpf(G8F(b.y, 3)); }
        }
    }
    __device__ __forceinline__ void operator()(const f32x4 (&acc)[2][2][4][2], const Unit& u, int wr, int wc, int fr, int fq) const {
        const int row0 = u.pm * BM + wr * 64 + fr, col0 = u.pn * BM + wc * 32 + 8 * fq;
        constexpr float q = 1.0f / 255.0f;
#pragma unroll
        for (int ai = 0; ai < 2; ++ai) {
            u32x2_t gb[4][2];
#pragma unroll
            for (int m = 0; m < 4; ++m)
#pragma unroll
                for (int bj = 0; bj < 2; ++bj) gb[m][bj] = *(const u32x2_t*)(GB_ + (size_t)(row0 + ai * HALF + m * 16) * 4096 + col0 + bj * HALF);
#pragma unroll
            for (int m = 0; m < 4; ++m)
#pragma unroll
                for (int bj = 0; bj < 2; ++bj) { const u32x2_t b = gb[m][bj]; const f32x4 v0 = acc[ai][bj][m][0] * q, v1 = acc[ai][bj][m][1] * q;
                    u32x4 w; w.x = cvt_pk_bf16(v0[0] * G8F(b.x, 0), v0[1] * G8F(b.x, 1)); w.y = cvt_pk_bf16(v0[2] * G8F(b.x, 2), v0[3] * G8F(b.x, 3));
                    w.z = cvt_pk_bf16(v1[0] * G8F(b.y, 0), v1[1] * G8F(b.y, 1)); w.w = cvt_pk_bf16(v1[2] * G8F(b.y, 2), v1[3] * G8F(b.y, 3));
                    *(u32x4*)(O + (size_t)(row0 + ai * HALF + m * 16) * 4096 + col0 + bj * HALF) = w; }
        }
    }
};
struct EpiBf16Plain {
    static constexpr bool PERM = true, AFTER_DRAIN = false; static constexpr int MID_T = -1;
    bf16_t* O; int ldc;
    __device__ __forceinline__ void operator()(const f32x4 (&acc)[2][2][4][2], const Unit& u, int wr, int wc, int fr, int fq) const {
        const int row0 = u.pm * BM + wr * 64 + fr, col0 = u.pn * BM + wc * 32 + 8 * fq;
#pragma unroll
        for (int ai = 0; ai < 2; ++ai)
#pragma unroll
            for (int m = 0; m < 4; ++m) { bf16_t* rowp = O + (size_t)(row0 + ai * HALF + m * 16) * ldc + col0;
#pragma unroll
                for (int bj = 0; bj < 2; ++bj) { const f32x4 v0 = acc[ai][bj][m][0], v1 = acc[ai][bj][m][1];
                    u32x4 w; w.x = cvt_pk_bf16(v0[0], v0[1]); w.y = cvt_pk_bf16(v0[2], v0[3]); w.z = cvt_pk_bf16(v1[0], v1[1]); w.w = cvt_pk_bf16(v1[2], v1[3]);
                    *(u32x4*)(rowp + bj * HALF) = w; } }
    }
};

typedef int i32x4 __attribute__((ext_vector_type(4))); typedef int i32x8 __attribute__((ext_vector_type(8)));
template <class Epi, class Sched, bool ALIGN_EPI = false, bool SP2 = false, bool Q8 = false>
__device__ __forceinline__ void gemm_phase(PG8_LAS unsigned char* lds, const Gemm g, const Sched& S, const Epi& E) {
    const int wid = S.wv, lane = lane_now(), tid = wid * 64 + lane, wr = wid >> 2, wc = wid & 3, fr = lane & 15, fq = lane >> 4;
    const int K = g.K, nt = K / BK;
    unsigned voffA[2], voffB[2];
#pragma unroll
    for (int i = 0; i < 2; ++i) { int R, C; stage_rc(tid * 16 + i * 8192, R, C); const int Rb = Epi::PERM ? ((R & ~31) + perm32(R & 31)) : R;
        voffA[i] = (unsigned)(R * K + C) * 2u; voffB[i] = (unsigned)(Rb * K + C) * 2u; }
    const size_t kstep = (size_t)(BK * 2);
    const size_t hstep = (size_t)HALF * K * 2;
    const size_t tstep = 2 * hstep;
    const unsigned ldsb = (unsigned)(__UINTPTR_TYPE__)lds;
    const unsigned ldsw = (unsigned)wid * 1024u;
    const int aoff = lds_byte(wr * 64 + fr, fq * 8), boff = lds_byte(wc * 32 + fr, fq * 8);
#define PG8_SA(b, h) (((b) * 2 + (h)) * HTB)
#define PG8_SB(b, h) ((4 + (b) * 2 + (h)) * HTB)
#define PG8_STAGE(bufoff, gbase, voff) do { _Pragma("unroll") for (int _i = 0; _i < 2; ++_i) { const unsigned _m0 = ldsb + (unsigned)(bufoff) + ldsw + (unsigned)_i * 8192u; \
        asm volatile("s_mov_b32 m0, %2\n\ts_nop 0\n\tglobal_load_lds_dwordx4 %0, %1" :: "v"((voff)[_i]), "s"((const char*)(gbase)), "s"(_m0) : "m0", "memory"); } } while (0)
#define PG8_LDA(dst, b, h) do { _Pragma("unroll") for (int m = 0; m < 4; ++m) _Pragma("unroll") for (int k = 0; k < 2; ++k) dst[m][k] = *(const PG8_LAS bf16x8*)(lds + PG8_SA(b, h) + aoff + m * 2048 + k * 1024); } while (0)
#define PG8_LDB(dst, b, h) do { _Pragma("unroll") for (int n = 0; n < 2; ++n) _Pragma("unroll") for (int k = 0; k < 2; ++k) dst[n][k] = *(const PG8_LAS bf16x8*)(lds + PG8_SB(b, h) + boff + n * 2048 + k * 1024); } while (0)
#define PG8_MMA(ai, bj, At, Bt) do { __builtin_amdgcn_s_setprio(1); _Pragma("unroll") for (int m = 0; m < 4; ++m) _Pragma("unroll") for (int n = 0; n < 2; ++n) { \
        if constexpr (Q8) { _Pragma("unroll") for (int k = 0; k < 2; ++k) acc[ai][bj][m][n] = __builtin_bit_cast(f32x4, __builtin_amdgcn_mfma_i32_16x16x64_i8(__builtin_bit_cast(i32x4, Bt[n][k]), __builtin_bit_cast(i32x4, At[m][k]), __builtin_bit_cast(i32x4, acc[ai][bj][m][n]), 0, 0, 0)); } \
        else { _Pragma("unroll") for (int k = 0; k < 2; ++k) acc[ai][bj][m][n] = __builtin_amdgcn_mfma_f32_16x16x32_bf16(Bt[n][k], At[m][k], acc[ai][bj][m][n], 0, 0, 0); } } \
        __builtin_amdgcn_s_setprio(0); } while (0)
#define PG8_WAIT_V(n) asm volatile("s_waitcnt vmcnt(" #n ")" ::: "memory")
#define PG8_WAIT_L(n) asm volatile("s_waitcnt lgkmcnt(" #n ")" ::: "memory")
#define PG8_BAR __builtin_amdgcn_s_barrier()
#define PG8_SCHED __builtin_amdgcn_sched_barrier(0)
    Unit cur, nxt; int ui = 0;
    if (!S.next(0, cur)) return;
    f32x4 acc[2][2][4][2];
#pragma unroll
    for (int a = 0; a < 2; ++a)
#pragma unroll
        for (int b = 0; b < 2; ++b)
#pragma unroll
            for (int m = 0; m < 4; ++m)
#pragma unroll
                for (int n = 0; n < 2; ++n) acc[a][b][m][n] = (f32x4){0.f, 0.f, 0.f, 0.f};
    bf16x8 At[4][2], B0[2][2], B1[2][2];
    const char* cA = (const char*)g.A + (size_t)cur.pm * tstep; const char* cB = (const char*)g.Bt + (size_t)cur.pn * tstep;
    S.a_ready(cur);
    if constexpr (SP2) {
        PG8_STAGE(PG8_SB(0, 0), cB, voffB); PG8_STAGE(PG8_SB(0, 1), cB + hstep, voffB); PG8_STAGE(PG8_SA(0, 0), cA, voffA); PG8_STAGE(PG8_SA(0, 1), cA + hstep, voffA);
        if (wr == 1) PG8_BAR;
        PG8_WAIT_V(2); PG8_BAR;
        PG8_STAGE(PG8_SB(1, 0), cB + kstep, voffB); PG8_STAGE(PG8_SA(1, 0), cA + kstep, voffA); PG8_STAGE(PG8_SB(1, 1), cB + hstep + kstep, voffB);
        PG8_WAIT_V(6); PG8_BAR;
    } else {
        PG8_STAGE(PG8_SB(0, 0), cB, voffB); PG8_STAGE(PG8_SA(0, 0), cA, voffA); PG8_STAGE(PG8_SB(0, 1), cB + hstep, voffB); PG8_STAGE(PG8_SA(0, 1), cA + hstep, voffA);
        if (wr == 1) PG8_BAR;
        PG8_WAIT_V(4); PG8_BAR;
        PG8_STAGE(PG8_SB(1, 0), cB + kstep, voffB); PG8_STAGE(PG8_SA(1, 0), cA + kstep, voffA); PG8_STAGE(PG8_SB(1, 1), cB + hstep + kstep, voffB);
        PG8_WAIT_V(6); PG8_BAR;
    }
    for (;;) {
        const bool has_next = S.next(ui + 1, nxt);
        const char* nA = has_next ? (const char*)g.A + (size_t)nxt.pm * tstep : cA; const char* nB = has_next ? (const char*)g.Bt + (size_t)nxt.pn * tstep : cB;
        for (int t = 0; t < nt; t += 2) {
            if constexpr (Epi::MID_T >= 0) { if (t == Epi::MID_T) E.mid(acc, cur, wr, wc, fr, fq); }
            const bool last = (t == nt - 2);
            const char* a1 = cA + (size_t)(t + 1) * kstep;
            const char* a2 = last ? nA : cA + (size_t)(t + 2) * kstep; const char* b2 = last ? nB : cB + (size_t)(t + 2) * kstep;
            const char* a3 = a2 + kstep; const char* b3 = b2 + kstep;
            if (last && has_next) S.a_ready(nxt);
            if constexpr (SP2) {
            PG8_LDB(B0, 0, 0); PG8_LDB(B1, 0, 1); PG8_SCHED; PG8_LDA(At, 0, 0); PG8_STAGE(PG8_SA(1, 1), a1 + hstep, voffA);
            PG8_WAIT_V(8); PG8_WAIT_L(0); PG8_BAR; PG8_MMA(0, 0, At, B0); PG8_MMA(0, 1, At, B1); PG8_BAR; PG8_SCHED;
            PG8_LDA(At, 0, 1); PG8_STAGE(PG8_SB(0, 0), b2, voffB); PG8_STAGE(PG8_SB(0, 1), b2 + hstep, voffB); PG8_STAGE(PG8_SA(0, 0), a2, voffA);
            PG8_WAIT_V(8); PG8_WAIT_L(0); PG8_BAR; PG8_MMA(1, 0, At, B0); PG8_MMA(1, 1, At, B1); PG8_BAR; PG8_SCHED;
            PG8_LDB(B0, 1, 0); PG8_LDB(B1, 1, 1); PG8_SCHED; PG8_LDA(At, 1, 0); PG8_STAGE(PG8_SA(0, 1), a2 + hstep, voffA);
            PG8_WAIT_V(8); PG8_WAIT_L(0); PG8_BAR; PG8_MMA(0, 0, At, B0); PG8_MMA(0, 1, At, B1); PG8_BAR; PG8_SCHED;
            PG8_LDA(At, 1, 1); PG8_STAGE(PG8_SB(1, 0), b3, voffB); PG8_STAGE(PG8_SB(1, 1), b3 + hstep, voffB); PG8_STAGE(PG8_SA(1, 0), a3, voffA);
            PG8_WAIT_V(8); PG8_WAIT_L(0); PG8_BAR; PG8_MMA(1, 0, At, B0); PG8_MMA(1, 1, At, B1); PG8_BAR; PG8_SCHED;
            } else {
            PG8_LDB(B0, 0, 0); PG8_SCHED; PG8_LDA(At, 0, 0); PG8_STAGE(PG8_SA(1, 1), a1 + hstep, voffA);
            PG8_WAIT_L(8); PG8_BAR; PG8_WAIT_L(0); PG8_MMA(0, 0, At, B0); PG8_BAR; PG8_SCHED;
            PG8_LDB(B1, 0, 1); PG8_STAGE(PG8_SB(0, 0), b2, voffB);
            PG8_BAR; PG8_WAIT_L(0); PG8_MMA(0, 1, At, B1); PG8_BAR;
            PG8_LDA(At, 0, 1); PG8_STAGE(PG8_SA(0, 0), a2, voffA);
            PG8_BAR; PG8_WAIT_L(0); PG8_MMA(1, 0, At, B0); PG8_BAR; PG8_SCHED;
            PG8_STAGE(PG8_SB(0, 1), b2 + hstep, voffB);
            PG8_WAIT_V(6); PG8_BAR; PG8_MMA(1, 1, At, B1); PG8_BAR;
            PG8_LDB(B0, 1, 0); PG8_SCHED; PG8_LDA(At, 1, 0); PG8_STAGE(PG8_SA(0, 1), a2 + hstep, voffA);
            PG8_WAIT_L(8); PG8_BAR; PG8_WAIT_L(0); PG8_MMA(0, 0, At, B0); PG8_BAR; PG8_SCHED;
            PG8_LDB(B1, 1, 1); PG8_STAGE(PG8_SB(1, 0), b3, voffB);
            PG8_BAR; PG8_WAIT_L(0); PG8_MMA(0, 1, At, B1); PG8_BAR;
            PG8_LDA(At, 1, 1); PG8_STAGE(PG8_SA(1, 0), a3, voffA);
            PG8_BAR; PG8_WAIT_L(0); PG8_MMA(1, 0, At, B0); PG8_BAR; PG8_SCHED;
            PG8_STAGE(PG8_SB(1, 1), b3 + hstep, voffB);
            PG8_WAIT_V(6); PG8_BAR; PG8_MMA(1, 1, At, B1); PG8_BAR;
            }
        }
        if constexpr (ALIGN_EPI) { if (wr == 0) PG8_BAR; }
        if constexpr (!Epi::AFTER_DRAIN) { const int lz = lane_now();
            E(acc, cur, wr, wc, lz & 15, lz >> 4); S.done(cur); }
        if (!has_next) break;
#pragma unroll
        for (int a = 0; a < 2; ++a)
#pragma unroll
            for (int b = 0; b < 2; ++b)
#pragma unroll
                for (int m = 0; m < 4; ++m)
#pragma unroll
                    for (int n = 0; n < 2; ++n) acc[a][b][m][n] = (f32x4){0.f, 0.f, 0.f, 0.f};
        cur = nxt; cA = nA; cB = nB; ++ui;
        if constexpr (ALIGN_EPI) { if (wr == 1) PG8_BAR; }
    }
    PG8_WAIT_V(0);
    if constexpr (!ALIGN_EPI) { if (wr == 0) PG8_BAR; }
    PG8_BAR;
    if constexpr (Epi::AFTER_DRAIN) { E.fused(acc, cur, wr, wc, fr, fq, lds, wid, lane); S.done(cur); }
#undef PG8_SA
#undef PG8_SB
#undef PG8_STAGE
#undef PG8_LDA
#undef PG8_LDB
#undef PG8_MMA
#undef PG8_WAIT_V
#undef PG8_WAIT_L
#undef PG8_BAR
#undef PG8_SCHED
}
}

#ifndef MK_N_LAUNCHES
#define MK_N_LAUNCHES 1
#endif
static_assert(MK_N_LAUNCHES == 1, "P0 carries a grid barrier inside: one-launch build only");
constexpr int BATCH = 2, SEQ = 8192, D = 4096, DFF = 11008, M = BATCH * SEQ;
constexpr int DH = 2048, NH = 16, HD = 128;
constexpr int NIN = 22528, NUP = 2 * DFF;
constexpr int NPROJ = (7 - NQ8S) * 2048, NGATE = NQ8S * 2048 + 8192;
__host__ __device__ constexpr int win_src_bf(int d) { return bf_seg(d >> 11) * 2048 + (d & 2047); }
__host__ __device__ constexpr int win_src_q8(int d) { return d < NQ8S * 2048 ? q8_seg(d >> 11) * 2048 + (d & 2047) : 14336 + (d - NQ8S * 2048); }
constexpr float NORM_EPS = 1e-6f;
constexpr int NWAVES = 8;
constexpr int NPHASE = 14;

constexpr size_t MiB = 1u << 20;
constexpr size_t WS_CTL = 0, CTL_ZERO_BYTES = 65536;
constexpr size_t WS_CMD1 = 32768, WS_CMD2 = 49152;
constexpr size_t WS_SAH = 1 * MiB + 524288;
constexpr size_t WS_HQ = 1502 * MiB;
constexpr size_t WS_CM1 = 65536, WS_CM2 = WS_CM1 + (size_t)2 * DFF * 4, WS_CMG = WS_CM2 + (size_t)2 * DFF * 4;
constexpr size_t WS_SA1 = 1 * MiB + 262144, WS_SA2 = WS_SA1 + 65536, WS_SAG = WS_SA2 + 65536;
constexpr size_t WS_LB = 1 * MiB;
constexpr size_t WS_DSEG = 1 * MiB + 65536;
constexpr size_t WS_SEND = 2 * MiB;
constexpr size_t WS_W13_1 = 18 * MiB, WS_W2_1 = 190 * MiB, WS_W13_2 = 276 * MiB, WS_W2_2 = 448 * MiB;
constexpr size_t WS_WIN = 534 * MiB, WS_WUA = 710 * MiB, WS_WUB = 726 * MiB, WS_WO = 742 * MiB;
constexpr size_t WS_XN = 774 * MiB;
constexpr size_t WS_YAB = WS_XN;
constexpr size_t WS_Y = 902 * MiB;
constexpr size_t WS_F = WS_Y, WS_QA = WS_Y + 128 * MiB, WS_IA = WS_Y + 192 * MiB, WS_T = WS_Y;
constexpr size_t WS_BIG = 1158 * MiB;
constexpr size_t WS_HID = WS_BIG, WS_GA = WS_BIG, WS_QB = WS_BIG + 64 * MiB, WS_KB = WS_BIG + 128 * MiB, WS_VB = WS_BIG + 192 * MiB, WS_GTA = WS_BIG + 256 * MiB, WS_GTB = WS_BIG + 384 * MiB;
constexpr size_t WS_MX = WS_BIG;
constexpr size_t WS_END = 1674 * MiB;
static_assert(WS_W13_1 + (size_t)NUP * D * 2 == WS_W2_1 && WS_W2_1 + (size_t)D * DFF * 2 == WS_W13_2 && WS_W13_2 + (size_t)NUP * D * 2 == WS_W2_2 && WS_W2_2 + (size_t)D * DFF * 2 == WS_WIN, "ws map (ffn weights)");
static_assert(WS_WIN + (size_t)NIN * D * 2 == WS_WUA && WS_WUA + (size_t)D * DH * 2 == WS_WUB && WS_WUB + (size_t)D * DH * 2 == WS_WO && WS_WO + (size_t)D * D * 2 == WS_XN, "ws map (mixer weights)");
static_assert(WS_XN + (size_t)M * D * 2 == WS_Y && WS_Y + (size_t)M * D * 4 == WS_BIG && WS_HID + (size_t)M * DFF * 2 == WS_HQ && WS_HQ + (size_t)M * DFF == WS_END && WS_GTB + (size_t)M * D * 2 <= WS_HQ + 168 * MiB, "ws map (activations)");
constexpr int CW_BAR = 4096;

constexpr int RING_OFF = 0, RING_BYTES = 131072;
constexpr int LDSCTL_OFF = RING_BYTES, MISC_OFF = LDSCTL_OFF + 320;
constexpr int LDS_BYTES = 147456;

#define GAS __attribute__((address_space(1)))
#define LAS __attribute__((address_space(3)))
typedef unsigned short bf16;
typedef unsigned v4u __attribute__((ext_vector_type(4)));
typedef unsigned v2u __attribute__((ext_vector_type(2)));
typedef float f32x4 __attribute__((ext_vector_type(4)));
typedef float f32x16 __attribute__((ext_vector_type(16)));
typedef short bf16x8 __attribute__((ext_vector_type(8)));
typedef short s16x4 __attribute__((ext_vector_type(4)));
typedef GAS unsigned gu32;
#define RLX_AGENT __ATOMIC_RELAXED, __HIP_MEMORY_SCOPE_AGENT
#define LDS_WAIT() asm volatile("s_waitcnt lgkmcnt(0)" ::: "memory")
#define VM_WAIT() asm volatile("s_waitcnt vmcnt(0)" ::: "memory")
__device__ __forceinline__ unsigned f2bf(float f) { unsigned u = __builtin_bit_cast(unsigned, f); return (u + 0x7fffu + ((u >> 16) & 1u)) >> 16; }
__device__ __forceinline__ unsigned pk2(float lo, float hi) { return pg8::cvt_pk_bf16(lo, hi); }
__device__ __forceinline__ float bflo(unsigned u) { return __uint_as_float(u << 16); }
__device__ __forceinline__ float bfhi(unsigned u) { return __uint_as_float(u & 0xffff0000u); }
#define XB_TMO      128
#define XB_XCNT(j)  (256  + 64 * (j))
#define XB_XSUB(j)  (1280 + 64 * (j))
#define XB_XGEN(j)  (2304 + 64 * (j))
#define XB_TOP      3328
#define XB_TOPGEN   3392
#define XCD_BAR_WORDS 3456
#define XB_SPIN_CAP (1u << 18)

__device__ __forceinline__ unsigned xb_ld(unsigned* p)              { return __hip_atomic_load(p, __ATOMIC_RELAXED, __HIP_MEMORY_SCOPE_AGENT); }
__device__ __forceinline__ unsigned xb_add(unsigned* p, unsigned v) { return __hip_atomic_fetch_add(p, v, __ATOMIC_RELAXED, __HIP_MEMORY_SCOPE_AGENT); }
__device__ __forceinline__ unsigned xb_xcc_id() { return (unsigned)__builtin_amdgcn_s_getreg((3 << 11) | 20) & 0xFu; }
#define XB_SPIN(cond, bar) do { unsigned _sp = 0; while (cond) { __builtin_amdgcn_s_sleep(1); \
    if ((++_sp & 255u) == 0u) { if (xb_ld(&(bar)[XB_TMO])) break; if (_sp > XB_SPIN_CAP) { atomicAdd(&(bar)[XB_TMO], 1u); break; } } } } while (0)

struct XcdBarrier {
    unsigned* bar; unsigned x;
    volatile LAS unsigned* st;
    bool w0;
};

__device__ __forceinline__ XcdBarrier xcd_barrier_post(unsigned* bar, volatile LAS unsigned* st, bool w0) {
    XcdBarrier b; b.bar = bar; b.x = xb_xcc_id(); b.st = st; b.w0 = w0;
    if (w0 && lane_now() == 0) (void)xb_add(&bar[XB_XCNT(b.x)], 1u);
    return b;
}
__device__ __forceinline__ void xcd_barrier_complete(unsigned* bar, unsigned x, unsigned& nloc, unsigned& nx) {
    const unsigned G = gridDim.x * gridDim.y * gridDim.z;
    unsigned sum, cnt, mine, sp = 0u;
    for (;;) {
        sum = 0u; cnt = 0u; mine = 0u;
#pragma unroll
        for (unsigned j = 0; j < 16; ++j) { const unsigned c = xb_ld(&bar[XB_XCNT(j)]); sum += c; cnt += (c > 0u) ? 1u : 0u; mine = (j == x) ? c : mine; }
        if (sum == G) break;
        __builtin_amdgcn_s_sleep(1);
        if ((++sp & 255u) == 0u) { if (xb_ld(&bar[XB_TMO])) break; if (sp > XB_SPIN_CAP) { atomicAdd(&bar[XB_TMO], 1u); break; } }
    }
    nloc = mine > 0u ? mine : 1u; nx = cnt > 0u ? cnt : 1u;
}

__device__ __forceinline__ void xcd_barrier(const XcdBarrier& b) {
    asm volatile("s_waitcnt vmcnt(0)" ::: "memory");
    __syncthreads();
    if (b.w0 && lane_now() == 0) {
        unsigned* bar = b.bar;
        __builtin_amdgcn_s_waitcnt(0);
        unsigned nloc = b.st[0], nx = b.st[1];
        if (nloc == 0u) { xcd_barrier_complete(bar, b.x, nloc, nx); b.st[0] = nloc; b.st[1] = nx; }
        const unsigned old = xb_add(&bar[XB_XSUB(b.x)], 1u);
        const unsigned gen = old / nloc;
        if (old + 1u == (gen + 1u) * nloc) {
            __builtin_amdgcn_fence(__ATOMIC_RELEASE, "agent");
            asm volatile("s_waitcnt vmcnt(0)" ::: "memory");
            const unsigned og = xb_add(&bar[XB_TOP], 1u);
            const unsigned tg = og / nx;
            if (og + 1u == (tg + 1u) * nx) xb_add(&bar[XB_TOPGEN], 1u);
            else XB_SPIN(xb_ld(&bar[XB_TOPGEN]) == tg, bar);
            __builtin_amdgcn_fence(__ATOMIC_ACQUIRE, "agent");
            xb_add(&bar[XB_XGEN(b.x)], 1u);
            asm volatile("s_waitcnt vmcnt(0)" ::: "memory");
        } else {
            XB_SPIN(xb_ld(&bar[XB_XGEN(b.x)]) == gen, bar);
            __builtin_amdgcn_fence(__ATOMIC_ACQUIRE, "agent");
            asm volatile("s_waitcnt vmcnt(0)" ::: "memory");
        }
    }
    __syncthreads();
}


__device__ __forceinline__ float wave_sum(float v) {
#pragma unroll
    for (int o = 1; o < 64; o <<= 1) v += __shfl_xor(v, o);
    return v;
}
__device__ __forceinline__ void tr_item(const float* __restrict__ W, int K, int N, bf16* __restrict__ WT, int k0, int n0, int dst_row0, LAS float* scr, int lane, int kd0 = -1) {
    if (kd0 < 0) kd0 = k0;
#pragma unroll 8
    for (int i = 0; i < 32; ++i) { const int kk = 2 * i + (lane >> 5); scr[kk * 33 + (lane & 31)] = W[(size_t)(k0 + kk) * N + n0 + (lane & 31)]; }
    LDS_WAIT(); asm volatile("" ::: "memory");
    const int c = lane & 7;
#pragma unroll
    for (int j = 0; j < 4; ++j) { const int n = (lane >> 3) + 8 * j; const LAS float* s = scr + (8 * c) * 33 + n;
        v4u o; o.x = pk2(s[0 * 33], s[1 * 33]); o.y = pk2(s[2 * 33], s[3 * 33]); o.z = pk2(s[4 * 33], s[5 * 33]); o.w = pk2(s[6 * 33], s[7 * 33]);
        *(GAS v4u*)(WT + (size_t)(dst_row0 + n) * K + kd0 + 8 * c) = o; }
    LDS_WAIT(); asm volatile("" ::: "memory");
}
__device__ __forceinline__ void tr_plain(const float* W, int K, int N, bf16* WT, int r, LAS float* scr, int lane) {
    const int nblk = N / 32, kb = r / nblk, nb = r % nblk; tr_item(W, K, N, WT, 64 * kb, 32 * nb, 32 * nb, scr, lane);
}
__device__ __forceinline__ void tr_glu(const float* W, bf16* WT, int half, int r, LAS float* scr, int lane) {
    const int nblk = DFF / 32, kb = r / nblk, nb = r % nblk, n0 = 32 * nb; tr_item(W, D, DFF, WT, 64 * kb, n0, 256 * (n0 >> 7) + (n0 & 127) + 128 * half, scr, lane);
}
__device__ __forceinline__ float wave_max(float v) {
#pragma unroll
    for (int o = 1; o < 64; o <<= 1) v = fmaxf(v, __shfl_xor(v, o));
    return v;
}
__device__ __forceinline__ int q8(float x) { return (int)__builtin_rintf(x); }
__device__ __forceinline__ unsigned pk4_i8(float a, float b, float c, float d) {
    const float MG = 12582912.0f;
    const unsigned ua = __float_as_uint(a + MG), ub = __float_as_uint(b + MG), uc = __float_as_uint(c + MG), ud = __float_as_uint(d + MG);
    return __builtin_amdgcn_perm(ub, ua, 0x0c0c0400u) | (__builtin_amdgcn_perm(ud, uc, 0x0c0c0400u) << 16);
}
__device__ __forceinline__ void wg_q8_item(const float* __restrict__ W, int N, int n0, unsigned char* __restrict__ WT8, int dst_row0, float* CM, LAS unsigned char* lds, int wave, int lane) {
    LAS float* scr = (LAS float*)(lds + wave * 16384);
    LAS float* cmL = (LAS float*)(lds + 12288);
    LAS float* cfin = cmL + 256;
    {   f32x4 mx = (f32x4){0.f, 0.f, 0.f, 0.f};
        const float* src = W + (size_t)(512 * wave + (lane >> 3)) * N + n0 + 4 * (lane & 7);
#pragma unroll 8
        for (int r = 0; r < 64; ++r) { const f32x4 v = *(const GAS f32x4*)(src + (size_t)(8 * r) * N);
            mx.x = fmaxf(mx.x, fabsf(v.x)); mx.y = fmaxf(mx.y, fabsf(v.y)); mx.z = fmaxf(mx.z, fabsf(v.z)); mx.w = fmaxf(mx.w, fabsf(v.w)); }
#pragma unroll
        for (int o = 8; o < 64; o <<= 1) { mx.x = fmaxf(mx.x, __shfl_xor(mx.x, o)); mx.y = fmaxf(mx.y, __shfl_xor(mx.y, o)); mx.z = fmaxf(mx.z, __shfl_xor(mx.z, o)); mx.w = fmaxf(mx.w, __shfl_xor(mx.w, o)); }
        if (lane < 8) *(LAS f32x4*)(cmL + wave * 32 + 4 * lane) = mx; }
    __syncthreads();
    if (wave == 0 && lane < 32) { float c = cmL[lane];
#pragma unroll
        for (int w = 1; w < 8; ++w) c = fmaxf(c, cmL[w * 32 + lane]);
        cfin[lane] = c; CM[dst_row0 + lane] = c; }
    __syncthreads();
    const int c8 = lane & 7;
    float inv[4];
#pragma unroll
    for (int j = 0; j < 4; ++j) { const float cmv = cfin[(lane >> 3) + 8 * j]; inv[j] = cmv > 0.f ? 127.0f / cmv : 0.f; }
    for (int ch = 0; ch < 8; ++ch) {
        const int k0 = 512 * wave + 64 * ch;
#pragma unroll 8
        for (int i = 0; i < 32; ++i) { const int kk = 2 * i + (lane >> 5); scr[kk * 33 + (lane & 31)] = W[(size_t)(k0 + kk) * N + n0 + (lane & 31)]; }
        LDS_WAIT(); asm volatile("" ::: "memory");
#pragma unroll
        for (int j = 0; j < 4; ++j) { const int n = (lane >> 3) + 8 * j; const LAS float* sp = scr + (8 * c8) * 33 + n;
            v2u o; o.x = pk4_i8(sp[0 * 33] * inv[j], sp[1 * 33] * inv[j], sp[2 * 33] * inv[j], sp[3 * 33] * inv[j]); o.y = pk4_i8(sp[4 * 33] * inv[j], sp[5 * 33] * inv[j], sp[6 * 33] * inv[j], sp[7 * 33] * inv[j]);
            *(GAS v2u*)(WT8 + (size_t)(dst_row0 + n) * 4096 + k0 + 8 * c8) = o; }
        LDS_WAIT(); asm volatile("" ::: "memory");
    }
    __syncthreads();
}
template <bool QUANT>
__device__ __forceinline__ void w2_had_item(const float* __restrict__ W, unsigned char* __restrict__ WT8, unsigned* CMX, int r, LAS float* scr, int lane, int nb0 = 0, int nblk = D / 32) {
    const int kb = r / nblk, nb = nb0 + r % nblk, k0 = 64 * kb, n0 = 32 * nb;
    float inv[4];
    if constexpr (QUANT) {
#pragma unroll
        for (int j = 0; j < 4; ++j) { const float cmv = __uint_as_float(CMX[n0 + (lane >> 3) + 8 * j]); inv[j] = cmv > 0.f ? 127.0f / cmv : 0.f; }
    }
#pragma unroll 8
    for (int i = 0; i < 32; ++i) { const int kk = 2 * i + (lane >> 5); scr[kk * 33 + (lane & 31)] = W[(size_t)(k0 + kk) * D + n0 + (lane & 31)]; }
    LDS_WAIT(); asm volatile("" ::: "memory");
    const int c = lane & 7;
#pragma unroll
    for (int j = 0; j < 4; ++j) { const int n = (lane >> 3) + 8 * j; const LAS float* sp = scr + (8 * c) * 33 + n;
        float v[8];
#pragma unroll
        for (int i = 0; i < 8; ++i) v[i] = sp[i * 33];
        wht8(v); wht_q<0xB1>(v, 1, lane); wht_q<0x4E>(v, 2, lane);
        if constexpr (!QUANT) {
            float mx = fmaxf(fmaxf(fmaxf(fabsf(v[0]), fabsf(v[1])), fmaxf(fabsf(v[2]), fabsf(v[3]))), fmaxf(fmaxf(fabsf(v[4]), fabsf(v[5])), fmaxf(fabsf(v[6]), fabsf(v[7]))));
            mx = fmaxf(mx, dpp_f<0xB1>(mx)); mx = fmaxf(mx, dpp_f<0x4E>(mx)); mx = fmaxf(mx, dpp_f<0x104>(mx));
            if (c == 0) (void)__hip_atomic_fetch_max(CMX + n0 + n, __float_as_uint(mx), RLX_AGENT);
        } else {
            const float iv = inv[j];
            v2u o; o.x = pk4_i8(v[0] * iv, v[1] * iv, v[2] * iv, v[3] * iv); o.y = pk4_i8(v[4] * iv, v[5] * iv, v[6] * iv, v[7] * iv);
            *(GAS v2u*)(WT8 + (size_t)(n0 + n) * DFF + k0 + 8 * c) = o; }
    }
    LDS_WAIT(); asm volatile("" ::: "memory");
}
template <bool QUANT>
__device__ __forceinline__ void w2_had_stream(const float* __restrict__ W, unsigned char* __restrict__ WT8, unsigned* CMX, int it0, int step, int nit, LAS float* scr, int lane, int nblk) {
    float v[32]; float cmn[4] = {0.f, 0.f, 0.f, 0.f};
    if (it0 < nit) { const int kb = it0 / nblk, nb = it0 % nblk; const float* src = W + (size_t)(64 * kb + (lane >> 5)) * D + 32 * nb + (lane & 31);
#pragma unroll
        for (int i = 0; i < 32; ++i) v[i] = src[(size_t)(2 * i) * D];
        if constexpr (QUANT) {
#pragma unroll
            for (int j = 0; j < 4; ++j) cmn[j] = __uint_as_float(CMX[32 * nb + (lane >> 3) + 8 * j]); } }
    for (int it = it0; it < nit; it += step) {
        const int kb = it / nblk, nb = it % nblk, k0 = 64 * kb, n0 = 32 * nb;
#pragma unroll
        for (int i = 0; i < 32; ++i) scr[(2 * i + (lane >> 5)) * 33 + (lane & 31)] = v[i];
        float inv[4];
#pragma unroll
        for (int j = 0; j < 4; ++j) inv[j] = cmn[j] > 0.f ? 127.0f / cmn[j] : 0.f;
        const int nx = it + step;
        if (nx < nit) { const int kb2 = nx / nblk, nb2 = nx % nblk; const float* src = W + (size_t)(64 * kb2 + (lane >> 5)) * D + 32 * nb2 + (lane & 31);
#pragma unroll
            for (int i = 0; i < 32; ++i) v[i] = src[(size_t)(2 * i) * D];
            if constexpr (QUANT) {
#pragma unroll
                for (int j = 0; j < 4; ++j) cmn[j] = __uint_as_float(CMX[32 * nb2 + (lane >> 3) + 8 * j]); } }
        LDS_WAIT(); asm volatile("" ::: "memory");
        const int c = lane & 7;
#pragma unroll
        for (int j = 0; j < 4; ++j) { const int n = (lane >> 3) + 8 * j; const LAS float* sp = scr + (8 * c) * 33 + n;
            float t[8];
#pragma unroll
            for (int i = 0; i < 8; ++i) t[i] = sp[i * 33];
            wht8(t); wht_q<0xB1>(t, 1, lane); wht_q<0x4E>(t, 2, lane);
            if constexpr (!QUANT) {
                float mx = fmaxf(fmaxf(fmaxf(fabsf(t[0]), fabsf(t[1])), fmaxf(fabsf(t[2]), fabsf(t[3]))), fmaxf(fmaxf(fabsf(t[4]), fabsf(t[5])), fmaxf(fabsf(t[6]), fabsf(t[7]))));
                mx = fmaxf(mx, dpp_f<0xB1>(mx)); mx = fmaxf(mx, dpp_f<0x4E>(mx)); mx = fmaxf(mx, dpp_f<0x104>(mx));
                if (c == 0) (void)__hip_atomic_fetch_max(CMX + n0 + n, __float_as_uint(mx), RLX_AGENT);
            } else {
                const float iv = inv[j];
                v2u o; o.x = pk4_i8(t[0] * iv, t[1] * iv, t[2] * iv, t[3] * iv); o.y = pk4_i8(t[4] * iv, t[5] * iv, t[6] * iv, t[7] * iv);
                *(GAS v2u*)(WT8 + (size_t)(n0 + n) * DFF + k0 + 8 * c) = o; }
        }
        LDS_WAIT(); asm volatile("" ::: "memory");
    }
}
__device__ __forceinline__ void hid_row_to_q8(const bf16* hrow, unsigned char* qrow, float* sa, int lane) {
    const GAS v2u* h4 = (const GAS v2u*)hrow + lane; GAS unsigned* o4 = (GAS unsigned*)qrow + lane;
    v2u hv[43];
#pragma unroll
    for (int i = 0; i < 43; ++i) hv[i] = h4[64 * i];
    float am = 0.f;
#pragma unroll
    for (int i = 0; i < 43; ++i) am = fmaxf(fmaxf(am, fmaxf(fabsf(bflo(hv[i].x)), fabsf(bfhi(hv[i].x)))), fmaxf(fabsf(bflo(hv[i].y)), fabsf(bfhi(hv[i].y))));
    am = wave_max(am); const float inv = am > 0.f ? 127.0f / am : 0.f;
    if (lane == 0) *sa = am * (1.0f / 127.0f);
#pragma unroll
    for (int i = 0; i < 43; ++i) { const v2u w = hv[i]; o4[64 * i] = pk4_i8(bflo(w.x) * inv, bfhi(w.x) * inv, bflo(w.y) * inv, bfhi(w.y) * inv); }
}
__device__ __forceinline__ void wg_q8_item_h(const float* __restrict__ W, int N, int n0, unsigned char* __restrict__ WT8, int dst_row0, float* CM, LAS unsigned char* lds, int wave, int lane) {
    LAS float* cmL = (LAS float*)(lds + MISC_OFF + 1024);
    LAS float* cfin = cmL + 256;
    v2u rp[8][4];
    {   f32x4 mx = (f32x4){0.f, 0.f, 0.f, 0.f};
        const int g = lane >> 3, q = lane & 7;
        const float* src = W + (size_t)(512 * wave + 4 * g) * N + n0 + 4 * q;
#pragma unroll 4
        for (int it = 0; it < 8; ++it) {
            f32x4 v[4];
#pragma unroll
            for (int j = 0; j < 4; ++j) v[j] = *(const GAS f32x4*)(src + (size_t)(32 * it + j) * N);
#pragma unroll
            for (int j = 0; j < 4; ++j) { mx.x = fmaxf(mx.x, fabsf(v[j].x)); mx.y = fmaxf(mx.y, fabsf(v[j].y)); mx.z = fmaxf(mx.z, fabsf(v[j].z)); mx.w = fmaxf(mx.w, fabsf(v[j].w)); }
            const int gr = (64 * wave + 8 * it + g) ^ (q << 1);
#pragma unroll
            for (int c = 0; c < 4; ++c) { v2u o; o.x = pg8::cvt_pk_bf16(v[0][c], v[1][c]); o.y = pg8::cvt_pk_bf16(v[2][c], v[3][c]); *(LAS v2u*)(lds + (4 * q + c) * 4096 + gr * 8) = o; }
        }
#pragma unroll
        for (int it = 0; it < 8; ++it) {
            f32x4 v[4];
#pragma unroll
            for (int j = 0; j < 4; ++j) v[j] = *(const GAS f32x4*)(src + (size_t)(256 + 32 * it + j) * N);
#pragma unroll
            for (int j = 0; j < 4; ++j) { mx.x = fmaxf(mx.x, fabsf(v[j].x)); mx.y = fmaxf(mx.y, fabsf(v[j].y)); mx.z = fmaxf(mx.z, fabsf(v[j].z)); mx.w = fmaxf(mx.w, fabsf(v[j].w)); }
#pragma unroll
            for (int c = 0; c < 4; ++c) { rp[it][c].x = pg8::cvt_pk_bf16(v[0][c], v[1][c]); rp[it][c].y = pg8::cvt_pk_bf16(v[2][c], v[3][c]); }
        }
#pragma unroll
        for (int o = 8; o < 64; o <<= 1) { mx.x = fmaxf(mx.x, __shfl_xor(mx.x, o)); mx.y = fmaxf(mx.y, __shfl_xor(mx.y, o)); mx.z = fmaxf(mx.z, __shfl_xor(mx.z, o)); mx.w = fmaxf(mx.w, __shfl_xor(mx.w, o)); }
        if (lane < 8) *(LAS f32x4*)(cmL + wave * 32 + 4 * lane) = mx; }
    __syncthreads();
    if (wave == 0 && lane < 32) { float c = cmL[lane];
#pragma unroll
        for (int w = 1; w < 8; ++w) c = fmaxf(c, cmL[w * 32 + lane]);
        c = bflo(pg8::cvt_pk_bf16(c, c));
        cfin[lane] = c; CM[dst_row0 + lane] = c; }
    __syncthreads();
#pragma unroll
    for (int h = 0; h < 4; ++h) { const int n = 4 * wave + h; const float cmv = cfin[n]; const float inv = cmv > 0.f ? 127.0f / cmv : 0.f;
        const LAS unsigned char* rowp = lds + n * 4096; const int sw = n >> 2;
#pragma unroll
        for (int i = 0; i < 4; ++i) { const int y = lane + 64 * i; const v4u w = *(const LAS v4u*)(rowp + ((y ^ sw) << 4));
            v2u o; o.x = pk4_i8(bflo(w.x) * inv, bfhi(w.x) * inv, bflo(w.y) * inv, bfhi(w.y) * inv); o.y = pk4_i8(bflo(w.z) * inv, bfhi(w.z) * inv, bflo(w.w) * inv, bfhi(w.w) * inv);
            *(GAS v2u*)(WT8 + (size_t)(dst_row0 + n) * 4096 + 512 * (y >> 5) + 8 * (y & 31)) = o; } }
    {   const int g = lane >> 3, q = lane & 7;
#pragma unroll
        for (int c = 0; c < 4; ++c) { const float cmv = cfin[4 * q + c]; const float iv = cmv > 0.f ? 127.0f / cmv : 0.f;
            unsigned char* rowp = WT8 + (size_t)(dst_row0 + 4 * q + c) * 4096 + 512 * wave + 256 + 4 * g;
#pragma unroll
            for (int it = 0; it < 8; ++it) *(GAS unsigned*)(rowp + 32 * it) = pk4_i8(bflo(rp[it][c].x) * iv, bfhi(rp[it][c].x) * iv, bflo(rp[it][c].y) * iv, bfhi(rp[it][c].y) * iv); } }
    __syncthreads();
}
__device__ __forceinline__ void rms_row_to_q8(const float* xrow, const float* g, unsigned char* qrow, float* sa, int lane) {
    asm volatile("" : "+s"(g));
    const GAS f32x4* xr = (const GAS f32x4*)xrow + lane; const GAS f32x4* gr = (const GAS f32x4*)g + lane;
    f32x4 v[16]; float s = 0.f;
#pragma unroll
    for (int j = 0; j < 16; ++j) { v[j] = xr[64 * j]; s += (v[j].x * v[j].x + v[j].y * v[j].y) + (v[j].z * v[j].z + v[j].w * v[j].w); }
    const float r = 1.0f / sqrtf(wave_sum(s) * (1.f / D) + NORM_EPS);
    float am = 0.f;
#pragma unroll
    for (int j = 0; j < 16; ++j) { const f32x4 gg = gr[64 * j]; v[j].x *= r * gg.x; v[j].y *= r * gg.y; v[j].z *= r * gg.z; v[j].w *= r * gg.w;
        am = fmaxf(am, fmaxf(fmaxf(fabsf(v[j].x), fabsf(v[j].y)), fmaxf(fabsf(v[j].z), fabsf(v[j].w)))); }
    am = wave_max(am); const float inv = am > 0.f ? 127.0f / am : 0.f;
    if (lane == 0) *sa = am * (1.0f / 127.0f);
    GAS unsigned* o4 = (GAS unsigned*)qrow + lane;
#pragma unroll
    for (int j = 0; j < 16; ++j) o4[64 * j] = pk4_i8(v[j].x * inv, v[j].y * inv, v[j].z * inv, v[j].w * inv);
}
__device__ __forceinline__ void rms_row_to_bf16(const float* xrow, const float* __restrict__ g, bf16* orow, int lane) {
    const GAS f32x4* xr = (const GAS f32x4*)xrow + lane; const GAS f32x4* gr = (const GAS f32x4*)g + lane;
    f32x4 v[16]; float s = 0.f;
#pragma unroll
    for (int j = 0; j < 16; ++j) { v[j] = xr[64 * j]; s += (v[j].x * v[j].x + v[j].y * v[j].y) + (v[j].z * v[j].z + v[j].w * v[j].w); }
    const float r = 1.0f / sqrtf(wave_sum(s) * (1.f / D) + NORM_EPS);
    GAS v2u* o8 = (GAS v2u*)orow + lane;
#pragma unroll
    for (int j = 0; j < 16; ++j) { const f32x4 gg = gr[64 * j]; v2u o; o.x = pk2(v[j].x * r * gg.x, v[j].y * r * gg.y); o.y = pk2(v[j].z * r * gg.z, v[j].w * r * gg.w); o8[64 * j] = o; }
}
template <bool HN, bool XI_BF, bool XO_BF, bool HB = true, bool H8 = false> __device__ __forceinline__ void post_row(const bf16* yrow, const void* xi, void* xo, const float* gpost, float wgt, const float* gpre, bf16* hrow, int lane, unsigned char* h8row = nullptr, float* sa = nullptr) {
    asm volatile("" : "+s"(gpost), "+s"(gpre));
    const GAS v4u* yr = (const GAS v4u*)yrow + lane;
    const GAS f32x4* gp = (const GAS f32x4*)gpost + 2 * lane;
    f32x4 v[8][2]; float s = 0.f;
    v4u xb[8]; f32x4 xf[8][2];
#pragma unroll
    for (int j = 0; j < 8; ++j) { if (XI_BF) xb[j] = ((const GAS v4u*)xi + lane)[64 * j]; else { xf[j][0] = ((const GAS f32x4*)xi + 2 * lane)[128 * j]; xf[j][1] = ((const GAS f32x4*)xi + 2 * lane)[128 * j + 1]; } }
#pragma unroll
    for (int j = 0; j < 8; ++j) { const v4u w = yr[64 * j]; v[j][0] = (f32x4){bflo(w.x), bfhi(w.x), bflo(w.y), bfhi(w.y)}; v[j][1] = (f32x4){bflo(w.z), bfhi(w.z), bflo(w.w), bfhi(w.w)};
#pragma unroll
        for (int e = 0; e < 2; ++e) s += (v[j][e].x * v[j][e].x + v[j][e].y * v[j][e].y) + (v[j][e].z * v[j][e].z + v[j][e].w * v[j][e].w); }
    const float r = wgt / sqrtf(wave_sum(s) * (1.f / D) + NORM_EPS);
    float s2 = 0.f;
#pragma unroll
    for (int j = 0; j < 8; ++j) {
        f32x4 xx[2];
        if (XI_BF) { const v4u w = xb[j]; xx[0] = (f32x4){bflo(w.x), bfhi(w.x), bflo(w.y), bfhi(w.y)}; xx[1] = (f32x4){bflo(w.z), bfhi(w.z), bflo(w.w), bfhi(w.w)}; }
        else { xx[0] = xf[j][0]; xx[1] = xf[j][1]; }
#pragma unroll
        for (int e = 0; e < 2; ++e) { const f32x4 gg = gp[128 * j + e];
            v[j][e].x = xx[e].x + v[j][e].x * r * gg.x; v[j][e].y = xx[e].y + v[j][e].y * r * gg.y; v[j][e].z = xx[e].z + v[j][e].z * r * gg.z; v[j][e].w = xx[e].w + v[j][e].w * r * gg.w;
            s2 += (v[j][e].x * v[j][e].x + v[j][e].y * v[j][e].y) + (v[j][e].z * v[j][e].z + v[j][e].w * v[j][e].w); }
        if (XO_BF) { v4u o; o.x = pk2(v[j][0].x, v[j][0].y); o.y = pk2(v[j][0].z, v[j][0].w); o.z = pk2(v[j][1].x, v[j][1].y); o.w = pk2(v[j][1].z, v[j][1].w); ((GAS v4u*)xo + lane)[64 * j] = o; }
        else { ((GAS f32x4*)xo + 2 * lane)[128 * j] = v[j][0]; ((GAS f32x4*)xo + 2 * lane)[128 * j + 1] = v[j][1]; }
    }
    if (HN) {
        const float r2 = 1.0f / sqrtf(wave_sum(s2) * (1.f / D) + NORM_EPS);
        const GAS f32x4* gq = (const GAS f32x4*)gpre + 2 * lane; float am = 0.f;
#pragma unroll
        for (int j = 0; j < 8; ++j)
#pragma unroll
            for (int e = 0; e < 2; ++e) { const f32x4 gg = gq[128 * j + e]; v[j][e].x *= r2 * gg.x; v[j][e].y *= r2 * gg.y; v[j][e].z *= r2 * gg.z; v[j][e].w *= r2 * gg.w;
                if (H8) am = fmaxf(am, fmaxf(fmaxf(fabsf(v[j][e].x), fabsf(v[j][e].y)), fmaxf(fabsf(v[j][e].z), fabsf(v[j][e].w)))); }
        if (HB) { GAS v4u* o16 = (GAS v4u*)hrow + lane;
#pragma unroll
            for (int j = 0; j < 8; ++j) { v4u o; o.x = pk2(v[j][0].x, v[j][0].y); o.y = pk2(v[j][0].z, v[j][0].w); o.z = pk2(v[j][1].x, v[j][1].y); o.w = pk2(v[j][1].z, v[j][1].w); o16[64 * j] = o; } }
        if (H8) { am = wave_max(am); const float inv = am > 0.f ? 127.0f / am : 0.f;
            if (lane == 0) *sa = am * (1.0f / 127.0f);
#pragma unroll
            for (int j = 0; j < 8; ++j) { v2u q; q.x = pk4_i8(v[j][0].x * inv, v[j][0].y * inv, v[j][0].z * inv, v[j][0].w * inv); q.y = pk4_i8(v[j][1].x * inv, v[j][1].y * inv, v[j][1].z * inv, v[j][1].w * inv);
                ((GAS v2u*)h8row + lane)[64 * j] = q; } }
    }
}

constexpr int HG_NSEG = 8, HG_SEGLEN = SEQ / HG_NSEG, HG_TB = 32;
struct HgT { const float* F; const bf16* QA; const bf16* IA; const bf16* GA; const float* normg; float* SEND; float* DSEG; bf16* YA; };
constexpr int AL_K = 0, AL_V = 34816, AL_BT = 69632, A_TILE = 17408, A_RS = 272;
struct AtT { const bf16* QB; const bf16* KB; const bf16* VB; const float* relb; bf16* YB; };
typedef float f32x2_t __attribute__((ext_vector_type(2)));
typedef __bf16 bf16x2_t __attribute__((ext_vector_type(2)));
__device__ __forceinline__ unsigned cvtpk_s(float lo, float hi) { f32x2_t v = {lo, hi}; bf16x2_t b = __builtin_convertvector(v, bf16x2_t); return __builtin_bit_cast(unsigned, b); }
__device__ __forceinline__ bf16x8 pack8(float a0, float a1, float a2, float a3, float a4, float a5, float a6, float a7) {
    v4u w; w.x = cvtpk_s(a0, a1); w.y = cvtpk_s(a2, a3); w.z = cvtpk_s(a4, a5); w.w = cvtpk_s(a6, a7); return __builtin_bit_cast(bf16x8, w);
}
__device__ __forceinline__ s16x4 vtr(const LAS unsigned char* p) { return __builtin_bit_cast(s16x4, __builtin_amdgcn_ds_read_tr16_b64_v4i16((LAS s16x4*)p)); }
__device__ __forceinline__ void attn_item(const AtT& T, LAS unsigned char* lds, int bh, int ib, int tid) {
    const int w = __builtin_amdgcn_readfirstlane(tid >> 6), lane = tid & 63, l31 = lane & 31, hh = lane >> 5;
    const int b = bh >> 4, h = bh & 15, c0 = 4 * ib, j = w >> 1;
    const size_t mq = (size_t)b * SEQ + 256 * ib + 32 * w + l31;
    LAS float* bt = (LAS float*)(lds + AL_BT);
    for (int i = tid; i < 513; i += 512) bt[i] = T.relb[h * 513 + i] * 1.4426950408889634f;
    bf16x8 qf[8];
#pragma unroll
    for (int ks = 0; ks < 8; ++ks) qf[ks] = *(const GAS bf16x8*)(T.QB + mq * DH + h * HD + 16 * ks + 8 * hh);
    f32x16 O[4];
#pragma unroll
    for (int d = 0; d < 4; ++d)
#pragma unroll
        for (int r = 0; r < 16; ++r) O[d][r] = 0.f;
    float m_run = -1e30f, l_run = 0.f;
    const int tt_lo = (8 - c0) > 0 ? (8 - c0) : 0;
    const int lr = tid >> 4, lc = tid & 15;
    v4u kreg[2], vreg[2];
#define AT_LOAD(tt) do { const size_t mk = (size_t)b * SEQ + (size_t)(64 * (c0 - 8 + (tt))); _Pragma("unroll") for (int i = 0; i < 2; ++i) { const size_t o = (mk + lr + 32 * i) * DH + h * HD + 8 * lc; \
        kreg[i] = *(const GAS v4u*)(T.KB + o); vreg[i] = *(const GAS v4u*)(T.VB + o); } } while (0)
#define AT_STORE(buf) do { _Pragma("unroll") for (int i = 0; i < 2; ++i) { const int o = (buf) * A_TILE + (lr + 32 * i) * A_RS + lc * 16; \
        *(LAS v4u*)(lds + AL_K + o) = kreg[i]; *(LAS v4u*)(lds + AL_V + o) = vreg[i]; } } while (0)
    AT_LOAD(tt_lo); AT_STORE(tt_lo & 1);
    __syncthreads();
    for (int tt = tt_lo; tt < 12; ++tt) {
        if (tt + 1 < 12) AT_LOAD(tt + 1);
        if (j <= tt && tt <= j + 8) {
            const int dist = j + 8 - tt;
            const LAS unsigned char* Kt = lds + AL_K + (tt & 1) * A_TILE; const LAS unsigned char* Vt = lds + AL_V + (tt & 1) * A_TILE;
            f32x16 s0, s1;
#pragma unroll
            for (int r = 0; r < 16; ++r) { s0[r] = 0.f; s1[r] = 0.f; }
#pragma unroll
            for (int ks = 0; ks < 8; ++ks) {
                const bf16x8 a0 = *(const LAS bf16x8*)(Kt + l31 * A_RS + (16 * ks + 8 * hh) * 2);
                const bf16x8 a1 = *(const LAS bf16x8*)(Kt + (32 + l31) * A_RS + (16 * ks + 8 * hh) * 2);
                s0 = __builtin_amdgcn_mfma_f32_32x32x16_bf16(a0, qf[ks], s0, 0, 0, 0);
                s1 = __builtin_amdgcn_mfma_f32_32x32x16_bf16(a1, qf[ks], s1, 0, 0, 0);
            }
            const int qi = 32 * (w & 1) + l31; const int relb0 = 64 * dist + qi - 4 * hh;
            float mx = -1e30f;
#pragma unroll
            for (int r = 0; r < 16; ++r) { const int ki = 8 * (r >> 2) + (r & 3); int i0 = relb0 - ki; int i1 = i0 - 32; i0 = (i0 > 256 ? 256 : i0) + 256; i1 = (i1 > 256 ? 256 : i1) + 256;
                s0[r] += bt[i0]; s1[r] += bt[i1]; mx = fmaxf(mx, fmaxf(s0[r], s1[r])); }
            mx = fmaxf(mx, __shfl_xor(mx, 32));
            const float m_new = fmaxf(m_run, mx); const float alpha = __builtin_amdgcn_exp2f(m_run - m_new); m_run = m_new;
            float ps = 0.f;
#pragma unroll
            for (int r = 0; r < 16; ++r) { s0[r] = __builtin_amdgcn_exp2f(s0[r] - m_new); s1[r] = __builtin_amdgcn_exp2f(s1[r] - m_new); ps += s0[r] + s1[r]; }
            l_run = l_run * alpha + ps;
#pragma unroll
            for (int d = 0; d < 4; ++d)
#pragma unroll
                for (int r = 0; r < 16; ++r) O[d][r] *= alpha;
            const int g = lane >> 4, tq = (lane & 15) >> 2, tp = lane & 3;
            const LAS unsigned char* vbase = Vt + (4 * hh + tq) * A_RS + (16 * (g & 1) + 4 * tp) * 2;
#pragma unroll
            for (int blk = 0; blk < 2; ++blk)
#pragma unroll
                for (int s = 0; s < 2; ++s) {
                    const bf16x8 pb = blk == 0 ? pack8(s0[8 * s + 0], s0[8 * s + 1], s0[8 * s + 2], s0[8 * s + 3], s0[8 * s + 4], s0[8 * s + 5], s0[8 * s + 6], s0[8 * s + 7])
                                               : pack8(s1[8 * s + 0], s1[8 * s + 1], s1[8 * s + 2], s1[8 * s + 3], s1[8 * s + 4], s1[8 * s + 5], s1[8 * s + 6], s1[8 * s + 7]);
#pragma unroll
                    for (int d = 0; d < 4; ++d) {
                        const LAS unsigned char* p = vbase + (32 * blk + 16 * s) * A_RS + 64 * d;
                        const s16x4 lo = vtr(p), hi = vtr(p + 8 * A_RS);
                        const bf16x8 va = (bf16x8){lo[0], lo[1], lo[2], lo[3], hi[0], hi[1], hi[2], hi[3]};
                        O[d] = __builtin_amdgcn_mfma_f32_32x32x16_bf16(va, pb, O[d], 0, 0, 0);
                    }
                }
        }
        if (tt + 1 < 12) AT_STORE((tt + 1) & 1);
        __syncthreads();
    }
#undef AT_LOAD
#undef AT_STORE
    const float lt = l_run + __shfl_xor(l_run, 32); const float inv = 1.0f / lt;
#pragma unroll
    for (int d = 0; d < 4; ++d)
#pragma unroll
        for (int rq = 0; rq < 4; ++rq) { v2u o; o.x = pk2(O[d][4 * rq] * inv, O[d][4 * rq + 1] * inv); o.y = pk2(O[d][4 * rq + 2] * inv, O[d][4 * rq + 3] * inv);
            *(GAS v2u*)(T.YB + mq * D + h * HD + 32 * d + 8 * rq + 4 * hh) = o; }
}

constexpr int H2_RS = 272, H2_ARR = 64 * H2_RS;
constexpr int H2_Q2 = 0, H2_QM = H2_ARR, H2_KM = 2 * H2_ARR, H2_KE = 3 * H2_ARR, H2_V = 4 * H2_ARR;
constexpr int H2_SB = 5 * H2_ARR;
constexpr int H2_TOT = H2_SB + 128 * H2_RS, H2_D = H2_TOT + 8 * 128 * 4, H2_SS = H2_D + 512, H2_END = H2_SS + 4 * 64 * 4;
static_assert(H2_END <= RING_BYTES, "HGRN2 LDS map");
template <bool OUT> __device__ __forceinline__ void hgrn2_item(const HgT& T, LAS unsigned char* lds, int bh, int seg, int tid) {
    const int w = __builtin_amdgcn_readfirstlane(tid >> 6), lane = tid & 63, l31 = lane & 31, hh = lane >> 5;
    const int tb = w & 1, vb = w >> 1, kp = lane;
    const int b = bh >> 4, h = bh & 15, c0 = h * HD;
    const size_t m0 = (size_t)b * SEQ + (size_t)seg * HG_SEGLEN;
    const int it0 = bh * HG_NSEG + seg;
    LAS float* tot = (LAS float*)(lds + H2_TOT); LAS float* dvec = (LAS float*)(lds + H2_D); LAS float* ssq = (LAS float*)(lds + H2_SS);
    const int g = lane >> 4, tq = (lane & 15) >> 2, tp = lane & 3;
    const int tr_off = tq * H2_RS + (16 * (g & 1) + 4 * tp) * 2;
    f32x16 S[2];
#pragma unroll
    for (int i = 0; i < 2; ++i)
#pragma unroll
        for (int r = 0; r < 16; ++r) S[i][r] = 0.f;
    if (OUT) {
        for (int j = 0; j < seg; ++j) { const int itj = bh * HG_NSEG + j;
#pragma unroll
            for (int i = 0; i < 2; ++i) { const int kb = 2 * (w & 1) + i;
#pragma unroll
                for (int rq = 0; rq < 4; ++rq) { const int k0 = 32 * kb + 8 * rq + 4 * hh; const f32x4 dj = *(const GAS f32x4*)(T.DSEG + itj * 128 + k0);
#pragma unroll
                    for (int e = 0; e < 4; ++e) S[i][4 * rq + e] = dj[e] * S[i][4 * rq + e] + T.SEND[((size_t)itj * 128 + k0 + e) * 128 + 32 * vb + l31]; } } }
#pragma unroll
        for (int i = 0; i < 2; ++i) { const int kb = 2 * (w & 1) + i;
#pragma unroll
            for (int rq = 0; rq < 4; ++rq) { v2u o; o.x = cvtpk_s(S[i][4 * rq], S[i][4 * rq + 1]); o.y = cvtpk_s(S[i][4 * rq + 2], S[i][4 * rq + 3]);
                *(LAS v2u*)(lds + H2_SB + (32 * vb + l31) * H2_RS + (32 * kb + 8 * rq + 4 * hh) * 2) = o; } }
    }
    float dtot0 = 1.f, dtot1 = 1.f;
    f32x2_t fr[8]; unsigned qr[8]; v4u vr[2];
    const int lr = tid >> 4, lc = tid & 15;
#define H2_LOAD(c) do { const size_t mrow_ = m0 + (size_t)(c) * 64; \
        _Pragma("unroll") for (int i = 0; i < 8; ++i) { const size_t o_ = (mrow_ + 8 * w + i) * DH + c0 + 2 * kp; fr[i] = *(const GAS f32x2_t*)(T.F + o_); if (OUT) qr[i] = *(const GAS unsigned*)(T.QA + o_); } \
        _Pragma("unroll") for (int i = 0; i < 2; ++i) vr[i] = *(const GAS v4u*)(T.IA + (mrow_ + lr + 32 * i) * DH + c0 + 8 * lc); } while (0)
    H2_LOAD(0);
    for (int c = 0; c < HG_SEGLEN / 64; ++c) {
        const size_t mrow = m0 + (size_t)c * 64;
        float pre0[8], pre1[8], suf0[8], suf1[8];
        { float a0 = 1.f, a1 = 1.f;
#pragma unroll
          for (int i = 0; i < 8; ++i) { a0 *= fr[i].x; a1 *= fr[i].y; pre0[i] = a0; pre1[i] = a1; }
          float s0 = 1.f, s1 = 1.f;
#pragma unroll
          for (int i = 7; i >= 0; --i) { suf0[i] = s0; suf1[i] = s1; s0 *= fr[i].x; s1 *= fr[i].y; } }
        *(LAS f32x2_t*)(tot + w * 128 + 2 * kp) = (f32x2_t){pre0[7], pre1[7]};
        __syncthreads();
        float ps0 = 1.f, ps1 = 1.f, pe0 = 1.f, pe1 = 1.f, pm0 = 1.f, pm1 = 1.f, pa0 = 1.f, pa1 = 1.f;
#pragma unroll
        for (int j = 0; j < 8; ++j) { const f32x2_t tj = *(const LAS f32x2_t*)(tot + j * 128 + 2 * kp);
            pa0 *= tj.x; pa1 *= tj.y;
            const bool cs = j < w, ce = j > w, cm = (w <= 3) ? (j > w && j <= 3) : (j >= 4 && j < w);
            ps0 *= cs ? tj.x : 1.0f; ps1 *= cs ? tj.y : 1.0f; pe0 *= ce ? tj.x : 1.0f; pe1 *= ce ? tj.y : 1.0f; pm0 *= cm ? tj.x : 1.0f; pm1 *= cm ? tj.y : 1.0f; }
        if (w == 0) { *(LAS f32x2_t*)(dvec + 2 * kp) = (f32x2_t){pa0, pa1}; dtot0 *= pa0; dtot1 *= pa1; }
#pragma unroll
        for (int i = 0; i < 8; ++i) {
            const int t = 8 * w + i;
            const float k0 = 1.0f - fr[i].x, k1 = 1.0f - fr[i].y;
            const float ee0 = suf0[i] * pe0, ee1 = suf1[i] * pe1;
            *(LAS unsigned*)(lds + H2_KE + t * H2_RS + 4 * kp) = cvtpk_s(k0 * ee0, k1 * ee1);
            if (OUT) {
                const float q0 = bflo(qr[i]), q1 = bfhi(qr[i]);
                const float es0 = ps0 * pre0[i], es1 = ps1 * pre1[i];
                float em0, em1, ei0, ei1;
                if (w <= 3) { ei0 = fmaxf(suf0[i] * pm0, 1e-30f); ei1 = fmaxf(suf1[i] * pm1, 1e-30f); em0 = __builtin_amdgcn_rcpf(ei0); em1 = __builtin_amdgcn_rcpf(ei1); }
                else        { em0 = fmaxf(pm0 * pre0[i], 1e-30f); em1 = fmaxf(pm1 * pre1[i], 1e-30f); ei0 = __builtin_amdgcn_rcpf(em0); ei1 = __builtin_amdgcn_rcpf(em1); }
                *(LAS unsigned*)(lds + H2_Q2 + t * H2_RS + 4 * kp) = cvtpk_s(q0 * es0, q1 * es1);
                *(LAS unsigned*)(lds + H2_QM + t * H2_RS + 4 * kp) = cvtpk_s(q0 * em0, q1 * em1);
                *(LAS unsigned*)(lds + H2_KM + t * H2_RS + 4 * kp) = cvtpk_s(k0 * ei0, k1 * ei1);
            }
        }
#pragma unroll
        for (int i = 0; i < 2; ++i) *(LAS v4u*)(lds + H2_V + (lr + 32 * i) * H2_RS + lc * 16) = vr[i];
        __syncthreads();
        if (c + 1 < HG_SEGLEN / 64) H2_LOAD(c + 1);
        v2u gq[4];
        if (OUT) {
#pragma unroll
            for (int rq = 0; rq < 4; ++rq) gq[rq] = *(const GAS v2u*)(T.GA + (mrow + 32 * tb + l31) * DH + c0 + 32 * vb + 8 * rq + 4 * hh);
        }
#pragma unroll
        for (int i = 0; i < 2; ++i) { const int kb = 2 * (w & 1) + i;
#pragma unroll
            for (int rq = 0; rq < 4; ++rq) { const f32x4 d4 = *(const LAS f32x4*)(dvec + 32 * kb + 8 * rq + 4 * hh);
#pragma unroll
                for (int e = 0; e < 4; ++e) S[i][4 * rq + e] *= d4[e]; } }
#pragma unroll
        for (int st = 0; st < 4; ++st) {
            const LAS unsigned char* pv = lds + H2_V + (16 * st + 8 * hh) * H2_RS + (32 * vb) * 2 + tr_off;
            const s16x4 v_lo = vtr(pv), v_hi = vtr(pv + 4 * H2_RS);
            const bf16x8 vfr = (bf16x8){v_lo[0], v_lo[1], v_lo[2], v_lo[3], v_hi[0], v_hi[1], v_hi[2], v_hi[3]};
#pragma unroll
            for (int i = 0; i < 2; ++i) { const int kb = 2 * (w & 1) + i;
                const LAS unsigned char* pk = lds + H2_KE + (16 * st + 8 * hh) * H2_RS + (32 * kb) * 2 + tr_off;
                const s16x4 k_lo = vtr(pk), k_hi = vtr(pk + 4 * H2_RS);
                const bf16x8 kfr = (bf16x8){k_lo[0], k_lo[1], k_lo[2], k_lo[3], k_hi[0], k_hi[1], k_hi[2], k_hi[3]};
                S[i] = __builtin_amdgcn_mfma_f32_32x32x16_bf16(kfr, vfr, S[i], 0, 0, 0); }
        }
        f32x16 oT;
        if (OUT) {
            f32x16 PT[2];
#pragma unroll
            for (int sb = 0; sb < 2; ++sb)
#pragma unroll
                for (int r = 0; r < 16; ++r) PT[sb][r] = 0.f;
#pragma unroll
            for (int ks = 0; ks < 8; ++ks) {
                const bf16x8 qb = *(const LAS bf16x8*)(lds + H2_QM + (32 * tb + l31) * H2_RS + 32 * ks + 16 * hh);
                const bf16x8 ka = *(const LAS bf16x8*)(lds + H2_KM + l31 * H2_RS + 32 * ks + 16 * hh);
                PT[0] = __builtin_amdgcn_mfma_f32_32x32x16_bf16(ka, qb, PT[0], 0, 0, 0);
                if (tb == 1) { const bf16x8 kb1 = *(const LAS bf16x8*)(lds + H2_KM + (32 + l31) * H2_RS + 32 * ks + 16 * hh);
                    PT[1] = __builtin_amdgcn_mfma_f32_32x32x16_bf16(kb1, qb, PT[1], 0, 0, 0); }
            }
#pragma unroll
            for (int r = 0; r < 16; ++r) { const int sl = 8 * (r >> 2) + 4 * hh + (r & 3); const bool drop = sl > l31;
                PT[0][r] = (drop && tb == 0) ? 0.f : PT[0][r]; PT[1][r] = (drop && tb == 1) ? 0.f : PT[1][r]; }
#pragma unroll
            for (int r = 0; r < 16; ++r) oT[r] = 0.f;
#pragma unroll
            for (int ks = 0; ks < 8; ++ks) {
                const bf16x8 sa = *(const LAS bf16x8*)(lds + H2_SB + (32 * vb + l31) * H2_RS + 32 * ks + 16 * hh);
                const bf16x8 qb = *(const LAS bf16x8*)(lds + H2_Q2 + (32 * tb + l31) * H2_RS + 32 * ks + 16 * hh);
                oT = __builtin_amdgcn_mfma_f32_32x32x16_bf16(sa, qb, oT, 0, 0, 0);
            }
#pragma unroll
            for (int sb = 0; sb < 2; ++sb) {
                if (sb <= tb) {
#pragma unroll
                    for (int s2 = 0; s2 < 2; ++s2) {
                        const bf16x8 pb = pack8(PT[sb][8 * s2 + 0], PT[sb][8 * s2 + 1], PT[sb][8 * s2 + 2], PT[sb][8 * s2 + 3], PT[sb][8 * s2 + 4], PT[sb][8 * s2 + 5], PT[sb][8 * s2 + 6], PT[sb][8 * s2 + 7]);
                        const LAS unsigned char* pv = lds + H2_V + (32 * sb + 16 * s2 + 4 * hh) * H2_RS + (32 * vb) * 2 + tr_off;
                        const s16x4 lo = vtr(pv), hi = vtr(pv + 8 * H2_RS);
                        const bf16x8 va = (bf16x8){lo[0], lo[1], lo[2], lo[3], hi[0], hi[1], hi[2], hi[3]};
                        oT = __builtin_amdgcn_mfma_f32_32x32x16_bf16(va, pb, oT, 0, 0, 0);
                    }
                }
            }
            float ss = 0.f;
#pragma unroll
            for (int r = 0; r < 16; ++r) ss += oT[r] * oT[r];
            ss += __shfl_xor(ss, 32);
            if (hh == 0) ssq[vb * 64 + 32 * tb + l31] = ss;
        }
        __syncthreads();
        if (OUT) {
            const int t = 32 * tb + l31;
            const float tot2 = (ssq[t] + ssq[64 + t]) + (ssq[128 + t] + ssq[192 + t]);
            const float rn = 1.0f / sqrtf(tot2 * (1.f / HD) + NORM_EPS);
#pragma unroll
            for (int rq = 0; rq < 4; ++rq) { v2u o; const f32x4 n4 = *(const GAS f32x4*)(T.normg + c0 + 32 * vb + 8 * rq + 4 * hh);
                o.x = pk2(oT[4 * rq] * rn * n4[0] * bflo(gq[rq].x), oT[4 * rq + 1] * rn * n4[1] * bfhi(gq[rq].x));
                o.y = pk2(oT[4 * rq + 2] * rn * n4[2] * bflo(gq[rq].y), oT[4 * rq + 3] * rn * n4[3] * bfhi(gq[rq].y));
                *(GAS v2u*)(T.YA + (mrow + t) * D + c0 + 32 * vb + 8 * rq + 4 * hh) = o; }
#pragma unroll
            for (int i = 0; i < 2; ++i) { const int kb = 2 * (w & 1) + i;
#pragma unroll
                for (int rq = 0; rq < 4; ++rq) { v2u o; o.x = cvtpk_s(S[i][4 * rq], S[i][4 * rq + 1]); o.y = cvtpk_s(S[i][4 * rq + 2], S[i][4 * rq + 3]);
                    *(LAS v2u*)(lds + H2_SB + (32 * vb + l31) * H2_RS + (32 * kb + 8 * rq + 4 * hh) * 2) = o; } }
        }
    }
#undef H2_LOAD
    if (!OUT) {
#pragma unroll
        for (int i = 0; i < 2; ++i) { const int kb = 2 * (w & 1) + i;
#pragma unroll
            for (int r = 0; r < 16; ++r) T.SEND[((size_t)it0 * 128 + 32 * kb + 8 * (r >> 2) + 4 * hh + (r & 3)) * 128 + 32 * vb + l31] = S[i][r]; }
        if (w == 0) *(GAS f32x2_t*)(T.DSEG + it0 * 128 + 2 * kp) = (f32x2_t){dtot0, dtot1};
    }
    __syncthreads();
}

struct Args { const float* in[21]; float* out; unsigned char* ws; int ph_lo, ph_hi, li, pad; };
__global__ void __launch_bounds__(NWAVES * 64, 2) mk_fwd(Args args) {
    extern __shared__ __attribute__((aligned(16))) unsigned char lds_raw[];
    LAS unsigned char* lds = (LAS unsigned char*)lds_raw;
    volatile LAS unsigned* MISC = (volatile LAS unsigned*)(lds + MISC_OFF);
    const int wave = __builtin_amdgcn_readfirstlane(threadIdx.x >> 6);
#define TID_HERE() const int lane = lane_now(), tid = wave * 64 + lane; (void)tid; (void)lane
    const int G = gridDim.x;
    unsigned char* ws = args.ws;
    gu32* ctl = (gu32*)(ws + WS_CTL);
    { TID_HERE(); for (int u = tid; u < (LDS_BYTES - LDSCTL_OFF) / 4; u += NWAVES * 64) ((LAS unsigned*)(lds + LDSCTL_OFF))[u] = 0u; }
    __syncthreads();
    XcdBarrier bar; bar.bar = (unsigned*)(ctl + CW_BAR); bar.x = 0; bar.st = nullptr; bar.w0 = (wave == 0);
    if (MK_N_LAUNCHES == 1) bar = xcd_barrier_post((unsigned*)(ctl + CW_BAR), MISC + 8, wave == 0);
#define GRID_BAR() do { if (MK_N_LAUNCHES == 1) xcd_barrier(bar); } while (0)
    const int lo = args.ph_lo, hi = args.ph_hi;
#define IN(k) (lo <= (k) && (k) < hi)
#define BOTH(k) (IN(k) && IN((k) + 1))
    const float* x = args.in[0]; float* out = args.out;
    bf16* W13_1 = (bf16*)(ws + WS_W13_1); bf16* W2_1 = (bf16*)(ws + WS_W2_1); bf16* W13_2 = (bf16*)(ws + WS_W13_2); bf16* W2_2 = (bf16*)(ws + WS_W2_2);
    bf16* WIN = (bf16*)(ws + WS_WIN); bf16* WUAB = (bf16*)(ws + WS_WUA); bf16* WO = (bf16*)(ws + WS_WO);
    bf16* XN = (bf16*)(ws + WS_XN); bf16* Y = (bf16*)(ws + WS_Y); bf16* HID = (bf16*)(ws + WS_HID);
    float* LB = (float*)(ws + WS_LB);
    bf16* X1B = (bf16*)(ws + WS_W13_1);
    unsigned char* XQG = ws + WS_W2_1;
    unsigned char* XQF = (unsigned char*)(ws + WS_XN);
    unsigned char* WGQ = ws + WS_WIN + (size_t)NPROJ * D * 2;
    unsigned char* W13Q_1 = ws + WS_W13_1; unsigned char* W13Q_2 = ws + WS_W13_2;
    float* CM1 = (float*)(ws + WS_CM1); float* CM2 = (float*)(ws + WS_CM2); float* CMG = (float*)(ws + WS_CMG);
    float* SA1 = (float*)(ws + WS_SA1); float* SA2 = (float*)(ws + WS_SA2); float* SAG = (float*)(ws + WS_SAG);
    unsigned* CMD1 = (unsigned*)(ws + WS_CMD1); unsigned* CMD2 = (unsigned*)(ws + WS_CMD2); float* SAH = (float*)(ws + WS_SAH);
    unsigned char* HQ = ws + WS_HQ;
    unsigned char* W2Q_1 = ws + WS_W2_1; unsigned char* W2Q_2 = ws + WS_W2_2;
    bf16* X2B = (bf16*)(ws + WS_WIN);
    const int gw = blockIdx.x * NWAVES + wave, NGW = G * NWAVES;

    if (IN(0)) {
        TID_HERE();
        LAS float* scr = (LAS float*)(lds + RING_OFF + wave * 16384);
        constexpr int I_2 = (DFF / 64) * (D / 32), I_IN = (D / 64) * (NPROJ / 32), I_U = (DH / 64) * (D / 32), I_O = (D / 64) * (D / 32);
        constexpr int Q_G = DFF / 32, Q_8 = NGATE / 32;
        if constexpr (DQ1 || DQ2) {
            if constexpr (DQ2) { constexpr int nb0 = TAILW2 ? TAILNB : 0, nbn = D / 32 - nb0; for (int it = gw; it < (DFF / 64) * nbn; it += NGW) w2_had_item<false>(args.in[20], nullptr, CMD2, it, scr, lane, nb0, nbn); }
            if constexpr (DQ1) for (int it = gw; it < I_2; it += NGW) w2_had_item<false>(args.in[5], nullptr, CMD1, it, scr, lane);
            GRID_BAR();
            if constexpr (DQ1) for (int it = gw; it < I_2; it += NGW) w2_had_item<true>(args.in[5], W2Q_1, CMD1, it, scr, lane);
        }
        __syncthreads();
        for (int it = blockIdx.x; it < 4 * Q_G + Q_8; it += G) {
            if (it < 4 * Q_G) { const int mat = it / Q_G, n0 = 32 * (it % Q_G);
                const float* W = mat == 0 ? args.in[3] : mat == 1 ? args.in[4] : mat == 2 ? args.in[18] : args.in[19];
                wg_q8_item_h(W, DFF, n0, mat < 2 ? W13Q_1 : W13Q_2, 256 * (n0 >> 7) + (n0 & 127) + 128 * (mat & 1), mat < 2 ? CM1 : CM2, lds, wave, lane); }
            else { const int d0 = 32 * (it - 4 * Q_G); wg_q8_item_h(args.in[8], NIN, win_src_q8(d0), WGQ, d0, CMG, lds, wave, lane); }
        }
        {
            constexpr int NA = 2 * I_2 + I_IN + 2 * I_U + I_O;
            for (int it = gw; it < NA; it += NGW) {
                int r = it;
                if (r < I_2) { if constexpr (!DQ1) tr_plain(args.in[5], DFF, D, W2_1, r, scr, lane); continue; } r -= I_2;
                if (r < I_2) { if constexpr (DQ2) { constexpr int nb0 = TAILW2 ? TAILNB : 0, nbn = D / 32 - nb0; if (r < (DFF / 64) * nbn) w2_had_item<true>(args.in[20], W2Q_2, CMD2, r, scr, lane, nb0, nbn); } else tr_plain(args.in[20], DFF, D, W2_2, r, scr, lane); continue; } r -= I_2;
                if (r < I_IN) { const int kb = r / (NPROJ / 32), nb = r % (NPROJ / 32); tr_item(args.in[8], D, NIN, WIN, 64 * kb, win_src_bf(32 * nb), 32 * nb, scr, lane); continue; } r -= I_IN;
                if (r < I_U) { const int kb = r / (D / 32), nb = r % (D / 32); tr_item(args.in[13], D, D, WUAB, 64 * kb, 32 * nb, 32 * nb, scr, lane, 64 * kb); continue; } r -= I_U;
                if (r < I_U) { const int kb = r / (D / 32), nb = r % (D / 32); tr_item(args.in[14], D, D, WUAB, 64 * kb, 32 * nb, 32 * nb, scr, lane, DH + 64 * kb); continue; } r -= I_U;
                tr_plain(args.in[15], D, D, WO, r, scr, lane);
            }
            if (blockIdx.x == 0) { for (int i = tid; i < DH; i += NWAVES * 64) { const float l0 = args.in[10][i], l1 = args.in[10][DH + i]; LB[i] = 1.0f / (1.0f + __expf(l1 - l0)); } }
            for (int m = gw; m < M; m += NGW) rms_row_to_q8(x + (size_t)m * D, args.in[1], XQF + (size_t)m * D, SA1 + m, lane);
        }
        if (BOTH(0)) GRID_BAR();
    }
    if (IN(1)) {
        pg8::Gemm g{(const bf16*)XQF, (const bf16*)W13Q_1, M, NUP, D / 2}; pg8::StaticOrder S; S.init(M, NUP, G, (int)blockIdx.x); S.wv = wave;
        pg8::EpiSwigluQ8T<DQ1> E{HID, DFF, SA1, CM1};
        pg8::gemm_phase<pg8::EpiSwigluQ8T<DQ1>, pg8::StaticOrder, true, true, true>(lds + RING_OFF, g, S, E);
        if constexpr (TAILW2) {
            const int nun = (M / 256) * (NUP / 256), tailc = nun % G, base = tailc ? tailc : 0, NI = G - base;
            if ((int)blockIdx.x >= base) { TID_HERE(); LAS float* scr = (LAS float*)(lds + RING_OFF + wave * 16384);
                w2_had_stream<false>(args.in[20], nullptr, CMD2, ((int)blockIdx.x - base) * NWAVES + wave, NI * NWAVES, (DFF / 64) * TAILNB, scr, lane, TAILNB); } }
        if (BOTH(1)) GRID_BAR();
        if constexpr (DQ1) { TID_HERE(); for (int m = gw; m < M; m += NGW) hid_row_to_q8(HID + (size_t)m * DFF, HQ + (size_t)m * DFF, SAH + m, lane); GRID_BAR(); }
    }
    if (IN(2)) {
        if constexpr (DQ1) { pg8::Gemm g{(const bf16*)HQ, (const bf16*)W2Q_1, M, D, DFF / 2}; pg8::StaticOrder S; S.init(M, D, G, (int)blockIdx.x); S.wv = wave;
            pg8::EpiBf16Q8 E{Y, D, SAH, (const float*)CMD1, 1.0f / 32.0f};
            pg8::gemm_phase<pg8::EpiBf16Q8, pg8::StaticOrder, true, true, true>(lds + RING_OFF, g, S, E); }
        else { pg8::Gemm g{HID, W2_1, M, D, DFF}; pg8::StaticOrder S; S.init(M, D, G, (int)blockIdx.x); S.wv = wave;
            pg8::EpiBf16Plain E{Y, D};
            pg8::gemm_phase<pg8::EpiBf16Plain, pg8::StaticOrder, true, true>(lds + RING_OFF, g, S, E); }
        if (BOTH(2)) GRID_BAR();
    }
    if (IN(3)) {
        TID_HERE();
        for (int m = gw; m < M; m += NGW) post_row<true, false, true, true, true>(Y + (size_t)m * D, x + (size_t)m * D, X1B + (size_t)m * D, args.in[2], 0.5f, args.in[6], XN + (size_t)m * D, lane, XQG + (size_t)m * D, SAG + m);
        if (BOTH(3)) GRID_BAR();
    }
    if (IN(4)) {
        { pg8::Gemm g{(const bf16*)XQG, (const bf16*)WGQ, M, NGATE, D / 2}; pg8::StaticOrder S; S.init(M, NGATE, G, (int)blockIdx.x); S.wv = wave;
          pg8::EpiGatesQ8 E{(bf16*)(ws + WS_GTA), (bf16*)(ws + WS_GTB), (float*)(ws + WS_F), LB, args.in[9], SAG, CMG,
                            (bf16*)(ws + WS_QA), (bf16*)(ws + WS_IA), (bf16*)(ws + WS_GA), (bf16*)(ws + WS_QB), (bf16*)(ws + WS_KB), (bf16*)(ws + WS_VB), 0.08838834764831845f * 1.4426950408889634f};
          pg8::gemm_phase<pg8::EpiGatesQ8, pg8::StaticOrder, true, true, true>(lds + RING_OFF, g, S, E); }
        { pg8::Gemm g{XN, WIN, M, NPROJ, D}; pg8::StaticOrder S; S.init(M, NPROJ, G, (int)blockIdx.x); S.wv = wave;
          pg8::EpiProj E{(bf16*)(ws + WS_QA), (bf16*)(ws + WS_IA), (bf16*)(ws + WS_GA), (bf16*)(ws + WS_QB), (bf16*)(ws + WS_KB), (bf16*)(ws + WS_VB),
                         0.08838834764831845f * 1.4426950408889634f};
          pg8::gemm_phase<pg8::EpiProj, pg8::StaticOrder, true, true>(lds + RING_OFF, g, S, E); }
        if (BOTH(4)) GRID_BAR();
    }
    const HgT HT{(const float*)(ws + WS_F), (const bf16*)(ws + WS_QA), (const bf16*)(ws + WS_IA), (const bf16*)(ws + WS_GA), args.in[11], (float*)(ws + WS_SEND), (float*)(ws + WS_DSEG), (bf16*)(ws + WS_YAB)};
    if (IN(5)) {
        TID_HERE();
        for (int it = blockIdx.x; it < 32 * HG_NSEG; it += G) { const int bh = it >> 3, seg = it & 7; if (seg < HG_NSEG - 1) hgrn2_item<false>(HT, lds, bh, seg, tid); }
        const AtT AT{(const bf16*)(ws + WS_QB), (const bf16*)(ws + WS_KB), (const bf16*)(ws + WS_VB), args.in[12], (bf16*)(ws + WS_YAB) + DH};
        for (int it = blockIdx.x; it < 1024; it += G) attn_item(AT, lds, it & 31, it >> 5, tid);
        if (BOTH(5)) GRID_BAR();
    }
    if (IN(6)) {
        TID_HERE();
        for (int it = blockIdx.x; it < 32 * HG_NSEG; it += G) hgrn2_item<true>(HT, lds, it >> 3, it & 7, tid);
        if (BOTH(6)) GRID_BAR();
    }
    if (IN(7)) {
        pg8::Gemm g{(const bf16*)(ws + WS_YAB), WUAB, M, D, D}; pg8::StaticOrder S; S.init(M, D, G, (int)blockIdx.x); S.wv = wave;
        pg8::EpiUpGate E{(bf16*)(ws + WS_MX), (const unsigned char*)(ws + WS_GTA), (const unsigned char*)(ws + WS_GTB)};
        pg8::gemm_phase<pg8::EpiUpGate, pg8::StaticOrder, true, true>(lds + RING_OFF, g, S, E);
        if (BOTH(7)) GRID_BAR();
    }
    if (IN(9)) {
        pg8::Gemm g{(const bf16*)(ws + WS_MX), WO, M, D, D}; pg8::StaticOrder S; S.init(M, D, G, (int)blockIdx.x); S.wv = wave;
        pg8::EpiBf16Plain E{Y, D};
        pg8::gemm_phase<pg8::EpiBf16Plain, pg8::StaticOrder, true, true>(lds + RING_OFF, g, S, E);
        if (BOTH(9)) GRID_BAR();
    }
    if (IN(10)) {
        TID_HERE();
        for (int m = gw; m < M; m += NGW) post_row<true, true, true, false, true>(Y + (size_t)m * D, X1B + (size_t)m * D, X2B + (size_t)m * D, args.in[7], 1.0f, args.in[16], nullptr, lane, XQF + (size_t)m * D, SA2 + m);
        if (BOTH(10)) GRID_BAR();
    }
    if (IN(11)) {
        pg8::Gemm g{(const bf16*)XQF, (const bf16*)W13Q_2, M, NUP, D / 2}; pg8::StaticOrder S; S.init(M, NUP, G, (int)blockIdx.x); S.wv = wave;
        pg8::EpiSwigluQ8T<DQ2> E{HID, DFF, SA2, CM2};
        pg8::gemm_phase<pg8::EpiSwigluQ8T<DQ2>, pg8::StaticOrder, true, true, true>(lds + RING_OFF, g, S, E);
        if constexpr (TAILW2) {
            const int nun = (M / 256) * (NUP / 256), tailc = nun % G, base = tailc ? tailc : 0, NI = G - base;
            if ((int)blockIdx.x >= base) { TID_HERE(); LAS float* scr = (LAS float*)(lds + RING_OFF + wave * 16384);
                w2_had_stream<true>(args.in[20], W2Q_2, CMD2, ((int)blockIdx.x - base) * NWAVES + wave, NI * NWAVES, (DFF / 64) * TAILNB, scr, lane, TAILNB); } }
        if (BOTH(11)) GRID_BAR();
        if constexpr (DQ2) { TID_HERE(); for (int m = gw; m < M; m += NGW) hid_row_to_q8(HID + (size_t)m * DFF, HQ + (size_t)m * DFF, SAH + m, lane); GRID_BAR(); }
    }
    if (IN(12)) {
        if constexpr (DQ2) { pg8::Gemm g{(const bf16*)HQ, (const bf16*)W2Q_2, M, D, DFF / 2}; pg8::StaticOrder S; S.init(M, D, G, (int)blockIdx.x); S.wv = wave;
            pg8::EpiBf16Q8 E{Y, D, SAH, (const float*)CMD2, 1.0f / 32.0f};
            pg8::gemm_phase<pg8::EpiBf16Q8, pg8::StaticOrder, true, true, true>(lds + RING_OFF, g, S, E); }
        else { pg8::Gemm g{HID, W2_2, M, D, DFF}; pg8::StaticOrder S; S.init(M, D, G, (int)blockIdx.x); S.wv = wave;
            pg8::EpiBf16Plain E{Y, D};
            pg8::gemm_phase<pg8::EpiBf16Plain, pg8::StaticOrder, true, true>(lds + RING_OFF, g, S, E); }
        if (BOTH(12)) GRID_BAR();
    }
    if (IN(13)) {
        TID_HERE();
        for (int m = gw; m < M; m += NGW) post_row<false, true, false>(Y + (size_t)m * D, X2B + (size_t)m * D, out + (size_t)m * D, args.in[17], 0.5f, nullptr, nullptr, lane);
    }
#undef IN
#undef BOTH
#undef GRID_BAR
}

extern "C" void kernel_launch(void* const* d_in, const int* in_sizes, int n_in, void* d_out, int out_size, void* d_ws, size_t ws_size, hipStream_t stream) {
    static int grid = 0;
    if (grid == 0) {
        if (n_in != 21 || in_sizes[0] != M * D || out_size != M * D || ws_size < WS_END) { fprintf(stderr, "kernel_launch: unexpected shapes: n_in %d, in0 %d, out %d, ws %zu (need %zu); nothing launched\n", n_in, n_in > 0 ? in_sizes[0] : -1, out_size, ws_size, (size_t)WS_END); grid = -1; return; }
        int dev = 0, cus = 0, per_cu = 0;
        if (hipGetDevice(&dev) != hipSuccess || hipDeviceGetAttribute(&cus, hipDeviceAttributeMultiprocessorCount, dev) != hipSuccess) { fprintf(stderr, "kernel_launch: device query failed\n"); grid = -1; return; }
        if (hipFuncSetAttribute((const void*)mk_fwd, hipFuncAttributeMaxDynamicSharedMemorySize, LDS_BYTES) != hipSuccess) { fprintf(stderr, "kernel_launch: hipFuncSetAttribute failed\n"); grid = -1; return; }
        if (hipOccupancyMaxActiveBlocksPerMultiprocessor(&per_cu, (const void*)mk_fwd, NWAVES * 64, LDS_BYTES) != hipSuccess || per_cu < 1)
            fprintf(stderr, "kernel_launch: note: occupancy query reports %d workgroups per CU\n", per_cu);
        (void)hipGetLastError();
        grid = cus;
    }
    if (grid < 0) return;
    if (hipMemsetAsync((char*)d_ws + WS_CTL, 0, CTL_ZERO_BYTES, stream) != hipSuccess) { fprintf(stderr, "kernel_launch: memset failed\n"); return; }
    Args a{};
    for (int i = 0; i < 21; ++i) a.in[i] = (const float*)d_in[i];
    a.out = (float*)d_out; a.ws = (unsigned char*)d_ws;
    for (int li = 0; li < MK_N_LAUNCHES; ++li) {
        if (MK_N_LAUNCHES == 1) { a.ph_lo = 0; a.ph_hi = NPHASE; } else { a.ph_lo = li; a.ph_hi = li + 1; }
        a.li = li;
        hipLaunchKernelGGL(mk_fwd, dim3(grid), dim3(NWAVES * 64), LDS_BYTES, stream, a);
        const hipError_t le = hipPeekAtLastError();
        if (le != hipSuccess) { fprintf(stderr, "kernel_launch: launch %d failed: %s\n", li, hipGetErrorName(le)); break; }
    }
}
```

```cpp
#include <hip/hip_runtime.h>
#include <cstdio>
#include <cstdint>
__device__ __forceinline__ int lane_now() { unsigned m = ~0u; asm volatile("" : "+s"(m)); return (int)__builtin_amdgcn_mbcnt_hi(m, __builtin_amdgcn_mbcnt_lo(m, 0u)); }
__device__ __forceinline__ void wht8(float (&v)[8]) {
#pragma unroll
    for (int h = 1; h < 8; h <<= 1)
#pragma unroll
        for (int i = 0; i < 8; i += 2 * h)
#pragma unroll
            for (int j = i; j < i + h; ++j) { const float a = v[j], b = v[j + h]; v[j] = a + b; v[j + h] = a - b; }
}
__device__ __forceinline__ void wht_x(float (&v)[8], int mask, int lane) {
    const float sg = (lane & mask) ? -1.0f : 1.0f;
#pragma unroll
    for (int i = 0; i < 8; ++i) { const float p = __shfl_xor(v[i], mask); v[i] = __builtin_fmaf(v[i], sg, p); }
}
template <int CTRL>
__device__ __forceinline__ float dpp_f(float x) { return __builtin_bit_cast(float, __builtin_amdgcn_update_dpp(0, __builtin_bit_cast(int, x), CTRL, 0xF, 0xF, true)); }
template <int CTRL>
__device__ __forceinline__ void wht_q(float (&v)[8], int mask, int lane) {
    const float sg = (lane & mask) ? -1.0f : 1.0f;
#pragma unroll
    for (int i = 0; i < 8; ++i) { const float p = dpp_f<CTRL>(v[i]); v[i] = __builtin_fmaf(v[i], sg, p); }
}
constexpr int NQ8S = 1;
__host__ __device__ constexpr int q8_seg(int s) { return NQ8S == 1 ? 1 : (s == 0 ? 1 : s == 1 ? 2 : 6); }
__host__ __device__ constexpr int bf_seg(int s) { return NQ8S == 1 ? (s == 0 ? 0 : s + 1) : (s == 0 ? 0 : s == 1 ? 3 : s == 2 ? 4 : 5); }
constexpr bool DQ1 = true, DQ2 = true;
constexpr int TAILNB = 80;
constexpr bool TAILW2 = DQ2;
namespace pg8 {
#define PG8_LAS __attribute__((address_space(3)))
typedef unsigned short bf16_t;
typedef short bf16x8 __attribute__((ext_vector_type(8)));
typedef float f32x4 __attribute__((ext_vector_type(4)));
typedef unsigned u32x4 __attribute__((ext_vector_type(4)));
typedef unsigned u32x2 __attribute__((ext_vector_type(2)));
constexpr int BM = 256, BK = 64, HALF = 128, HTB = HALF * BK * 2  , STAGE_BYTES = 8 * HTB, NXCD = 8, WGM = 4;

__host__ __device__ __forceinline__ int lds_byte(int r, int c) { const int st = (r >> 4) * 2 + (c >> 5), rr = r & 15, cc = c & 31, ob = rr * 64 + cc * 2; return st * 1024 + (ob ^ (((ob >> 9) & 1) << 5)); }
__host__ __device__ __forceinline__ void stage_rc(int b, int& R, int& C) { const int st = b / 1024, sb = b % 1024, swz = sb ^ (((sb >> 9) & 1) << 5); R = (st >> 1) * 16 + swz / 64; C = (st & 1) * 32 + (swz % 64) / 2; }
__host__ __device__ __forceinline__ int perm32(int rho) { const int n = rho >> 4, i = rho & 15; return 8 * (i >> 2) + 4 * n + (i & 3); }

struct Unit { int pm, pn; };
struct Gemm { const bf16_t* A; const bf16_t* Bt; int M, N, K; };

struct StaticOrder {
    int nM, nN, nwg, G, c, wv;
    __host__ __device__ void init(int M, int N, int G_, int c_) { nM = M / BM; nN = N / BM; nwg = nM * nN; G = G_; c = c_; }
    __host__ __device__ bool next(int i, Unit& u) const {
        const long L = (long)i * G + c; if (L >= nwg) return false;
        int wgid = (int)L; { const int q = nwg / NXCD, r = nwg % NXCD, xcd = wgid % NXCD, off = wgid / NXCD; wgid = (xcd < r ? xcd * (q + 1) : r * (q + 1) + (xcd - r) * q) + off; }
        const int nig = WGM * nN, gid = wgid / nig, fm = gid * WGM, gsz = (nM - fm) < WGM ? (nM - fm) : WGM;
        u.pm = fm + ((wgid % nig) % gsz); u.pn = (wgid % nig) / gsz; return true;
    }
    __device__ __forceinline__ void a_ready(const Unit&) const {}
    __device__ __forceinline__ void done(const Unit&) const {}
};

typedef float f32x2c_t __attribute__((ext_vector_type(2))); typedef __bf16 bf16x2c_t __attribute__((ext_vector_type(2)));
__device__ __forceinline__ unsigned cvt_pk_bf16(float lo, float hi) { f32x2c_t v = {lo, hi}; bf16x2c_t b = __builtin_convertvector(v, bf16x2c_t); return __builtin_bit_cast(unsigned, b); }
typedef unsigned u32x2_t __attribute__((ext_vector_type(2)));
__device__ __forceinline__ unsigned pk4_g8(float a, float b, float c, float d) {
    const float MG = 12582912.0f;
    const unsigned ua = __builtin_bit_cast(unsigned, fmaxf(a * 255.0f, 1.0f) + MG), ub = __builtin_bit_cast(unsigned, fmaxf(b * 255.0f, 1.0f) + MG);
    const unsigned uc = __builtin_bit_cast(unsigned, fmaxf(c * 255.0f, 1.0f) + MG), ud = __builtin_bit_cast(unsigned, fmaxf(d * 255.0f, 1.0f) + MG);
    return __builtin_amdgcn_perm(ub, ua, 0x0c0c0400u) | (__builtin_amdgcn_perm(ud, uc, 0x0c0c0400u) << 16);
}
#define G8F(u, i) ((float)(((u) >> (8 * (i))) & 0xffu))
__device__ __forceinline__ float sigm(float x) { return __builtin_amdgcn_rcpf(1.0f + __expf(-x)); }
__device__ __forceinline__ float siluf(float x) { return x * sigm(x); }
__device__ __forceinline__ float bflo(unsigned u) { return __uint_as_float(u << 16); }
__device__ __forceinline__ float bfhi(unsigned u) { return __uint_as_float(u & 0xffff0000u); }

struct EpiSwiglu {
    static constexpr bool PERM = true, AFTER_DRAIN = false; static constexpr int MID_T = -1;
    bf16_t* O; int ldc;
    __device__ __forceinline__ void operator()(const f32x4 (&acc)[2][2][4][2], const Unit& u, int wr, int wc, int fr, int fq) const {
        const int row0 = u.pm * BM + wr * 64 + fr, col0 = u.pn * HALF + wc * 32 + 8 * fq;
#pragma unroll
        for (int ai = 0; ai < 2; ++ai)
#pragma unroll
            for (int m = 0; m < 4; ++m) { bf16_t* rowp = O + (size_t)(row0 + ai * HALF + m * 16) * ldc + col0;
                const f32x4 a0 = acc[ai][0][m][0], a1 = acc[ai][0][m][1], b0 = acc[ai][1][m][0], b1 = acc[ai][1][m][1];
                f32x4 h0, h1;
#pragma unroll
                for (int j = 0; j < 4; ++j) { h0[j] = siluf(a0[j]) * b0[j]; h1[j] = siluf(a1[j]) * b1[j]; }
                u32x4 w; w.x = cvt_pk_bf16(h0[0], h0[1]); w.y = cvt_pk_bf16(h0[2], h0[3]); w.z = cvt_pk_bf16(h1[0], h1[1]); w.w = cvt_pk_bf16(h1[2], h1[3]);
                *(u32x4*)rowp = w; }
    }
};
struct EpiProj {
    static constexpr bool PERM = true, AFTER_DRAIN = false; static constexpr int MID_T = -1;
    bf16_t *QA, *IA, *GA, *QB, *KB, *VB; float qscale;
    __device__ __forceinline__ void operator()(const f32x4 (&acc)[2][2][4][2], const Unit& u, int wr, int wc, int fr, int fq) const {
        const int row0 = u.pm * BM + wr * 64 + fr, cw = wc * 32 + 8 * fq, pn = u.pn;
        {
            const int seg = bf_seg(pn >> 3); const int colt = (pn & 7) * 256 + cw;
            bf16_t* base = seg == 0 ? QA : seg == 2 ? IA : seg == 3 ? GA : seg == 4 ? QB : seg == 5 ? KB : VB;
            const bool do_silu = (seg == 0 || seg == 3); const float sc = (seg == 4) ? qscale : 1.0f;
#pragma unroll
            for (int ai = 0; ai < 2; ++ai)
#pragma unroll
                for (int m = 0; m < 4; ++m) { bf16_t* rowp = base + (size_t)(row0 + ai * HALF + m * 16) * 2048 + colt;
#pragma unroll
                    for (int bj = 0; bj < 2; ++bj) { f32x4 v0 = acc[ai][bj][m][0] * sc, v1 = acc[ai][bj][m][1] * sc;
                        if (do_silu) {
#pragma unroll
                            for (int j = 0; j < 4; ++j) { v0[j] = siluf(v0[j]); v1[j] = siluf(v1[j]); } }
                        u32x4 w; w.x = cvt_pk_bf16(v0[0], v0[1]); w.y = cvt_pk_bf16(v0[2], v0[3]); w.z = cvt_pk_bf16(v1[0], v1[1]); w.w = cvt_pk_bf16(v1[2], v1[3]);
                        *(u32x4*)(rowp + bj * HALF) = w; } }
        }
    }
};
__device__ __forceinline__ float i2f(float bits) { return (float)__builtin_bit_cast(int, bits); }
struct EpiGatesQ8 {
    static constexpr bool PERM = true, AFTER_DRAIN = false; static constexpr int MID_T = -1;
    bf16_t *GTA, *GTB; float* F; const float* lb; const float* bgate; const float* SA; const float* CM; bf16_t *QA, *IA, *GA, *QB, *KB, *VB; float qscale;
    __device__ __forceinline__ void operator()(const f32x4 (&acc)[2][2][4][2], const Unit& u, int wr, int wc, int fr, int fq) const {
        int row0 = u.pm * BM + wr * 64 + fr; const int cw = wc * 32 + 8 * fq, pn = u.pn;
        int qcol = pn * 256 + cw;
        asm volatile("" : "+v"(row0), "+v"(qcol));
        f32x4 cs[2][2];
#pragma unroll
        for (int bj = 0; bj < 2; ++bj)
#pragma unroll
            for (int n = 0; n < 2; ++n) cs[bj][n] = *(const f32x4*)(CM + qcol + bj * HALF + 4 * n) * (1.0f / 127.0f);
        const int seg = pn < 8 * NQ8S ? q8_seg(pn >> 3) : 7;
        if (seg != 1 && seg != 7) {
            const int colt = qcol & 2047;
            bf16_t* base = seg == 0 ? QA : seg == 2 ? IA : seg == 3 ? GA : seg == 4 ? QB : seg == 5 ? KB : VB;
            const bool do_silu = (seg == 0 || seg == 3); const float sc = (seg == 4) ? qscale : 1.0f;
#pragma unroll
            for (int ai = 0; ai < 2; ++ai)
#pragma unroll
                for (int m = 0; m < 4; ++m) { const int row = row0 + ai * HALF + m * 16; const float sa = SA[row] * sc; bf16_t* rowp = base + (size_t)row * 2048 + colt;
#pragma unroll
                    for (int bj = 0; bj < 2; ++bj) { f32x4 v0, v1;
#pragma unroll
                        for (int j = 0; j < 4; ++j) { v0[j] = i2f(acc[ai][bj][m][0][j]) * sa * cs[bj][0][j]; v1[j] = i2f(acc[ai][bj][m][1][j]) * sa * cs[bj][1][j]; }
                        if (do_silu) {
#pragma unroll
                            for (int j = 0; j < 4; ++j) { v0[j] = siluf(v0[j]); v1[j] = siluf(v1[j]); } }
                        u32x4 w; w.x = cvt_pk_bf16(v0[0], v0[1]); w.y = cvt_pk_bf16(v0[2], v0[3]); w.z = cvt_pk_bf16(v1[0], v1[1]); w.w = cvt_pk_bf16(v1[2], v1[3]);
                        *(u32x4*)(rowp + bj * HALF) = w; } }
        } else if (seg == 1) {
            const int colt = qcol & 2047;
            f32x4 lbv[2][2];
#pragma unroll
            for (int bj = 0; bj < 2; ++bj)
#pragma unroll
                for (int n = 0; n < 2; ++n) lbv[bj][n] = *(const f32x4*)(lb + colt + bj * HALF + 4 * n);
#pragma unroll
            for (int ai = 0; ai < 2; ++ai)
#pragma unroll
                for (int m = 0; m < 4; ++m) { const int row = row0 + ai * HALF + m * 16; const float sa = SA[row]; float* rowp = F + (size_t)row * 2048 + colt;
#pragma unroll
                    for (int bj = 0; bj < 2; ++bj)
#pragma unroll
                        for (int n = 0; n < 2; ++n) { f32x4 o;
#pragma unroll
                            for (int j = 0; j < 4; ++j) o[j] = lbv[bj][n][j] + (1.0f - lbv[bj][n][j]) * sigm(i2f(acc[ai][bj][m][n][j]) * sa * cs[bj][n][j]);
                            *(f32x4*)(rowp + bj * HALF + 4 * n) = o; } }
        } else {
            const int gcol = qcol - 2048 * NQ8S; const bool isB = gcol >= 4096;
            bf16_t* base = isB ? GTB : GTA; const int colt = gcol & 4095;
            f32x4 bv[2][2];
#pragma unroll
            for (int bj = 0; bj < 2; ++bj)
#pragma unroll
                for (int n = 0; n < 2; ++n) bv[bj][n] = *(const f32x4*)(bgate + gcol + bj * HALF + 4 * n);
#pragma unroll
            for (int ai = 0; ai < 2; ++ai)
#pragma unroll
                for (int m = 0; m < 4; ++m) { const int row = row0 + ai * HALF + m * 16; const float sa = SA[row]; unsigned char* rowp = (unsigned char*)base + (size_t)row * 4096 + colt;
#pragma unroll
                    for (int bj = 0; bj < 2; ++bj) { f32x4 v0, v1;
#pragma unroll
                        for (int j = 0; j < 4; ++j) { v0[j] = sigm(i2f(acc[ai][bj][m][0][j]) * sa * cs[bj][0][j] + bv[bj][0][j]); v1[j] = sigm(i2f(acc[ai][bj][m][1][j]) * sa * cs[bj][1][j] + bv[bj][1][j]); }
                        u32x2_t w; w.x = pk4_g8(v0[0], v0[1], v0[2], v0[3]); w.y = pk4_g8(v1[0], v1[1], v1[2], v1[3]);
                        *(u32x2_t*)(rowp + bj * HALF) = w; } }
        }
    }
};
template <bool HAD>
struct EpiSwigluQ8T {
    static constexpr bool PERM = true, AFTER_DRAIN = false; static constexpr int MID_T = -1;
    bf16_t* O; int ldc; const float* SA; const float* CM;
    __device__ __forceinline__ void operator()(const f32x4 (&acc)[2][2][4][2], const Unit& u, int wr, int wc, int fr, int fq) const {
        int row0 = u.pm * BM + wr * 64 + fr, cw = wc * 32 + 8 * fq;
        asm volatile("" : "+v"(row0), "+v"(cw));
        const int col0 = u.pn * HALF + cw, brow = u.pn * BM + cw;
        f32x4 cs[2][2];
#pragma unroll
        for (int bj = 0; bj < 2; ++bj)
#pragma unroll
            for (int n = 0; n < 2; ++n) cs[bj][n] = *(const f32x4*)(CM + brow + bj * HALF + 4 * n) * (1.0f / 127.0f);
        float sav[2][4];
#pragma unroll
        for (int ai = 0; ai < 2; ++ai)
#pragma unroll
            for (int m = 0; m < 4; ++m) sav[ai][m] = SA[row0 + ai * HALF + m * 16];
#pragma unroll
        for (int ai = 0; ai < 2; ++ai)
#pragma unroll
            for (int m = 0; m < 4; ++m) { const int row = row0 + ai * HALF + m * 16; const float sa = sav[ai][m]; bf16_t* rowp = O + (size_t)row * ldc + col0;
                float v[8];
#pragma unroll
                for (int j = 0; j < 4; ++j) { v[j] = siluf(i2f(acc[ai][0][m][0][j]) * sa * cs[0][0][j]) * (i2f(acc[ai][1][m][0][j]) * sa * cs[1][0][j]);
                                              v[4 + j] = siluf(i2f(acc[ai][0][m][1][j]) * sa * cs[0][1][j]) * (i2f(acc[ai][1][m][1][j]) * sa * cs[1][1][j]); }
                if constexpr (HAD) {
                    const int ln = fr + 16 * fq;
                    wht8(v); wht_x(v, 16, ln); wht_x(v, 32, ln);
                }
                u32x4 w; w.x = cvt_pk_bf16(v[0], v[1]); w.y = cvt_pk_bf16(v[2], v[3]); w.z = cvt_pk_bf16(v[4], v[5]); w.w = cvt_pk_bf16(v[6], v[7]);
                *(u32x4*)rowp = w; }
    }
};
struct EpiBf16Q8 {
    static constexpr bool PERM = true, AFTER_DRAIN = false; static constexpr int MID_T = -1;
    bf16_t* O; int ldc; const float* SA; const float* CM; float mul;
    __device__ __forceinline__ void operator()(const f32x4 (&acc)[2][2][4][2], const Unit& u, int wr, int wc, int fr, int fq) const {
        int row0 = u.pm * BM + wr * 64 + fr, col0 = u.pn * BM + wc * 32 + 8 * fq;
        asm volatile("" : "+v"(row0), "+v"(col0));
        f32x4 cs[2][2];
#pragma unroll
        for (int bj = 0; bj < 2; ++bj)
#pragma unroll
            for (int n = 0; n < 2; ++n) cs[bj][n] = *(const f32x4*)(CM + col0 + bj * HALF + 4 * n) * (mul / 127.0f);
#pragma unroll
        for (int ai = 0; ai < 2; ++ai)
#pragma unroll
            for (int m = 0; m < 4; ++m) { const int row = row0 + ai * HALF + m * 16; const float sa = SA[row]; bf16_t* rowp = O + (size_t)row * ldc + col0;
#pragma unroll
                for (int bj = 0; bj < 2; ++bj) { f32x4 v0, v1;
#pragma unroll
                    for (int j = 0; j < 4; ++j) { v0[j] = i2f(acc[ai][bj][m][0][j]) * sa * cs[bj][0][j]; v1[j] = i2f(acc[ai][bj][m][1][j]) * sa * cs[bj][1][j]; }
                    u32x4 w; w.x = cvt_pk_bf16(v0[0], v0[1]); w.y = cvt_pk_bf16(v0[2], v0[3]); w.z = cvt_pk_bf16(v1[0], v1[1]); w.w = cvt_pk_bf16(v1[2], v1[3]);
                    *(u32x4*)(rowp + bj * HALF) = w; } }
    }
};
struct EpiUpGate {
    static constexpr bool PERM = true, AFTER_DRAIN = false; static constexpr int MID_T = 32;
    bf16_t* O; const unsigned char* GA_; const unsigned char* GB_;
    __device__ __forceinline__ void mid(f32x4 (&acc)[2][2][4][2], const Unit& u, int wr, int wc, int fr, int fq) const {
        int row0 = u.pm * BM + wr * 64 + fr, col0 = u.pn * BM + wc * 32 + 8 * fq;
        asm volatile("" : "+v"(row0), "+v"(col0));
#pragma unroll
        for (int ai = 0; ai < 2; ++ai) {
            u32x2_t ga[4][2], gb[4][2];
#pragma unroll
            for (int m = 0; m < 4; ++m)
#pragma unroll
                for (int bj = 0; bj < 2; ++bj) { const size_t off = (size_t)(row0 + ai * HALF + m * 16) * 4096 + col0 + bj * HALF;
                    ga[m][bj] = *(const u32x2_t*)(GA_ + off); gb[m][bj] = *(const u32x2_t*)(GB_ + off); }
#pragma unroll
            for (int m = 0; m < 4; ++m)
#pragma unroll
                for (int bj = 0; bj < 2; ++bj) { const u32x2_t a = ga[m][bj], b = gb[m][bj];
                    acc[ai][bj][m][0][0] *= G8F(a.x, 0) * __builtin_amdgcn_rcpf(G8F(b.x, 0)); acc[ai][bj][m][0][1] *= G8F(a.x, 1) * __builtin_amdgcn_rcpf(G8F(b.x, 1));
                    acc[ai][bj][m][0][2] *= G8F(a.x, 2) * __builtin_amdgcn_rcpf(G8F(b.x, 2)); acc[ai][bj][m][0][3] *= G8F(a.x, 3) * __builtin_amdgcn_rcpf(G8F(b.x, 3));
                    acc[ai][bj][m][1][0] *= G8F(a.y, 0) * __builtin_amdgcn_rcpf(G8F(b.y, 0)); acc[ai][bj][m][1][1] *= G8F(a.y, 1) * __builtin_amdgcn_rcpf(G8F(b.y, 1));
                    acc[ai][bj][m][1][2] *= G8F(a.y, 2) * __builtin_amdgcn_rcpf(G8F(b.y, 2)); acc[ai][bj][m][1][3] *= G8F(a.y, 3) * __builtin_amdgcn_rcpf(G8F(b.y, 3)); }
        }
    }
    __device__ __forceinline__ void operator()(const f32x4 (&acc)[2][2][4][2], const Unit& u, int wr, int wc, int fr, int fq) const {
        const int row0 = u.pm * BM + wr * 64 + fr, col0 = u.pn * BM + wc * 32 + 8 * fq;
        constexpr float q = 1.0f / 255.0f;
#pragma unroll
        for (int ai = 0; ai < 2; ++ai) {
            u32x2_t gb[4][2];
#pragma unroll
            for (int m = 0; m < 4; ++m)
#pragma unroll
                for (int bj = 0; bj < 2; ++bj) gb[m][bj] = *(const u32x2_t*)(GB_ + (size_t)(row0 + ai * HALF + m * 16) * 4096 + col0 + bj * HALF);
#pragma unroll
            for (int m = 0; m < 4; ++m)
#pragma unroll
                for (int bj = 0; bj < 2; ++bj) { const u32x2_t b = gb[m][bj]; const f32x4 v0 = acc[ai][bj][m][0] * q, v1 = acc[ai][bj][m][1] * q;
                    u32x4 w; w.x = cvt_pk_bf16(v0[0] * G8F(b.x, 0), v0[1] * G8F(b.x, 1)); w.y = cvt_pk_bf16(v0[2] * G8F(b.x, 2), v0[3] * G8F(b.x, 3));
                    w.z = cvt_pk_bf16(v1[0] * G8F(b.y, 0), v1[1] * G8F(b.y, 1)); w.w = cvt_pk_bf16(v1[2] * G8F(b.y, 2), v1[3] * G8F(b.y, 3));
                    *(u32x4*)(O + (size_t)(row0 + ai * HALF + m * 16) * 4096 + col0 + bj * HALF) = w; }
        }
    }
};
struct EpiBf16Plain {
    static constexpr bool PERM = true, AFTER_DRAIN = false; static constexpr int MID_T = -1;
    bf16_t* O; int ldc;
    __device__ __forceinline__ void operator()(const f32x4 (&acc)[2][2][4][2], const Unit& u, int wr, int wc, int fr, int fq) const {
        const int row0 = u.pm * BM + wr * 64 + fr, col0 = u.pn * BM + wc * 32 + 8 * fq;
#pragma unroll
        for (int ai = 0; ai < 2; ++ai)
#pragma unroll
            for (int m = 0; m < 4; ++m) { bf16_t* rowp = O + (size_t)(row0 + ai * HALF + m * 16) * ldc + col0;
#pragma unroll
                for (int bj = 0; bj < 2; ++bj) { const f32x4 v0 = acc[ai][bj][m][0], v1 = acc[ai][bj][m][1];
                    u32x4 w; w.x = cvt_pk_bf16(v0[0], v0[1]); w.y = cvt_pk_bf16(v0[2], v0[3]); w.z = cvt_pk_bf16(v1[0], v1[1]); w.w = cvt_pk_bf16(v1[2], v1[3]);
                    *(u32x4*)(rowp + bj * HALF) = w; } }
    }
};

typedef int i32x4 __attribute__((ext_vector_type(4))); typedef int i32x8 __attribute__((ext_vector_type(8)));
template <class Epi, class Sched, bool ALIGN_EPI = false, bool SP2 = false, bool Q8 = false>
__device__ __forceinline__ void gemm_phase(PG8_LAS unsigned char* lds, const Gemm g, const Sched& S, const Epi& E) {
    const int wid = S.wv, lane = lane_now(), tid = wid * 64 + lane, wr = wid >> 2, wc = wid & 3, fr = lane & 15, fq = lane >> 4;
    const int K = g.K, nt = K / BK;
    unsigned voffA[2], voffB[2];
#pragma unroll
    for (int i = 0; i < 2; ++i) { int R, C; stage_rc(tid * 16 + i * 8192, R, C); const int Rb = Epi::PERM ? ((R & ~31) + perm32(R & 31)) : R;
        voffA[i] = (unsigned)(R * K + C) * 2u; voffB[i] = (unsigned)(Rb * K + C) * 2u; }
    const size_t kstep = (size_t)(BK * 2);
    const size_t hstep = (size_t)HALF * K * 2;
    const size_t tstep = 2 * hstep;
    const unsigned ldsb = (unsigned)(__UINTPTR_TYPE__)lds;
    const unsigned ldsw = (unsigned)wid * 1024u;
    const int aoff = lds_byte(wr * 64 + fr, fq * 8), boff = lds_byte(wc * 32 + fr, fq * 8);
#define PG8_SA(b, h) (((b) * 2 + (h)) * HTB)
#define PG8_SB(b, h) ((4 + (b) * 2 + (h)) * HTB)
#define PG8_STAGE(bufoff, gbase, voff) do { _Pragma("unroll") for (int _i = 0; _i < 2; ++_i) { const unsigned _m0 = ldsb + (unsigned)(bufoff) + ldsw + (unsigned)_i * 8192u; \
        asm volatile("s_mov_b32 m0, %2\n\ts_nop 0\n\tglobal_load_lds_dwordx4 %0, %1" :: "v"((voff)[_i]), "s"((const char*)(gbase)), "s"(_m0) : "m0", "memory"); } } while (0)
#define PG8_LDA(dst, b, h) do { _Pragma("unroll") for (int m = 0; m < 4; ++m) _Pragma("unroll") for (int k = 0; k < 2; ++k) dst[m][k] = *(const PG8_LAS bf16x8*)(lds + PG8_SA(b, h) + aoff + m * 2048 + k * 1024); } while (0)
#define PG8_LDB(dst, b, h) do { _Pragma("unroll") for (int n = 0; n < 2; ++n) _Pragma("unroll") for (int k = 0; k < 2; ++k) dst[n][k] = *(const PG8_LAS bf16x8*)(lds + PG8_SB(b, h) + boff + n * 2048 + k * 1024); } while (0)
#define PG8_MMA(ai, bj, At, Bt) do { __builtin_amdgcn_s_setprio(1); _Pragma("unroll") for (int m = 0; m < 4; ++m) _Pragma("unroll") for (int n = 0; n < 2; ++n) { \
        if constexpr (Q8) { _Pragma("unroll") for (int k = 0; k < 2; ++k) acc[ai][bj][m][n] = __builtin_bit_cast(f32x4, __builtin_amdgcn_mfma_i32_16x16x64_i8(__builtin_bit_cast(i32x4, Bt[n][k]), __builtin_bit_cast(i32x4, At[m][k]), __builtin_bit_cast(i32x4, acc[ai][bj][m][n]), 0, 0, 0)); } \
        else { _Pragma("unroll") for (int k = 0; k < 2; ++k) acc[ai][bj][m][n] = __builtin_amdgcn_mfma_f32_16x16x32_bf16(Bt[n][k], At[m][k], acc[ai][bj][m][n], 0, 0, 0); } } \
        __builtin_amdgcn_s_setprio(0); } while (0)
#define PG8_WAIT_V(n) asm volatile("s_waitcnt vmcnt(" #n ")" ::: "memory")
#define PG8_WAIT_L(n) asm volatile("s_waitcnt lgkmcnt(" #n ")" ::: "memory")
#define PG8_BAR __builtin_amdgcn_s_barrier()
#define PG8_SCHED __builtin_amdgcn_sched_barrier(0)
    Unit cur, nxt; int ui = 0;
    if (!S.next(0, cur)) return;
    f32x4 acc[2][2][4][2];
#pragma unroll
    for (int a = 0; a < 2; ++a)
#pragma unroll
        for (int b = 0; b < 2; ++b)
#pragma unroll
            for (int m = 0; m < 4; ++m)
#pragma unroll
                for (int n = 0; n < 2; ++n) acc[a][b][m][n] = (f32x4){0.f, 0.f, 0.f, 0.f};
    bf16x8 At[4][2], B0[2][2], B1[2][2];
    const char* cA = (const char*)g.A + (size_t)cur.pm * tstep; const char* cB = (const char*)g.Bt + (size_t)cur.pn * tstep;
    S.a_ready(cur);
    if constexpr (SP2) {
        PG8_STAGE(PG8_SB(0, 0), cB, voffB); PG8_STAGE(PG8_SB(0, 1), cB + hstep, voffB); PG8_STAGE(PG8_SA(0, 0), cA, voffA); PG8_STAGE(PG8_SA(0, 1), cA + hstep, voffA);
        if (wr == 1) PG8_BAR;
        PG8_WAIT_V(2); PG8_BAR;
        PG8_STAGE(PG8_SB(1, 0), cB + kstep, voffB); PG8_STAGE(PG8_SA(1, 0), cA + kstep, voffA); PG8_STAGE(PG8_SB(1, 1), cB + hstep + kstep, voffB);
        PG8_WAIT_V(6); PG8_BAR;
    } else {
        PG8_STAGE(PG8_SB(0, 0), cB, voffB); PG8_STAGE(PG8_SA(0, 0), cA, voffA); PG8_STAGE(PG8_SB(0, 1), cB + hstep, voffB); PG8_STAGE(PG8_SA(0, 1), cA + hstep, voffA);
        if (wr == 1) PG8_BAR;
        PG8_WAIT_V(4); PG8_BAR;
        PG8_STAGE(PG8_SB(1, 0), cB + kstep, voffB); PG8_STAGE(PG8_SA(1, 0), cA + kstep, voffA); PG8_STAGE(PG8_SB(1, 1), cB + hstep + kstep, voffB);
        PG8_WAIT_V(6); PG8_BAR;
    }
    for (;;) {
        const bool has_next = S.next(ui + 1, nxt);
        const char* nA = has_next ? (const char*)g.A + (size_t)nxt.pm * tstep : cA; const char* nB = has_next ? (const char*)g.Bt + (size_t)nxt.pn * tstep : cB;
        for (int t = 0; t < nt; t += 2) {
            if constexpr (Epi::MID_T >= 0) { if (t == Epi::MID_T) E.mid(acc, cur, wr, wc, fr, fq); }
            const bool last = (t == nt - 2);
            const char* a1 = cA + (size_t)(t + 1) * kstep;
            const char* a2 = last ? nA : cA + (size_t)(t + 2) * kstep; const char* b2 = last ? nB : cB + (size_t)(t + 2) * kstep;
            const char* a3 = a2 + kstep; const char* b3 = b2 + kstep;
            if (last && has_next) S.a_ready(nxt);
            if constexpr (SP2) {
            PG8_LDB(B0, 0, 0); PG8_LDB(B1, 0, 1); PG8_SCHED; PG8_LDA(At, 0, 0); PG8_STAGE(PG8_SA(1, 1), a1 + hstep, voffA);
            PG8_WAIT_V(8); PG8_WAIT_L(0); PG8_BAR; PG8_MMA(0, 0, At, B0); PG8_MMA(0, 1, At, B1); PG8_BAR; PG8_SCHED;
            PG8_LDA(At, 0, 1); PG8_STAGE(PG8_SB(0, 0), b2, voffB); PG8_STAGE(PG8_SB(0, 1), b2 + hstep, voffB); PG8_STAGE(PG8_SA(0, 0), a2, voffA);
            PG8_WAIT_V(8); PG8_WAIT_L(0); PG8_BAR; PG8_MMA(1, 0, At, B0); PG8_MMA(1, 1, At, B1); PG8_BAR; PG8_SCHED;
            PG8_LDB(B0, 1, 0); PG8_LDB(B1, 1, 1); PG8_SCHED; PG8_LDA(At, 1, 0); PG8_STAGE(PG8_SA(0, 1), a2 + hstep, voffA);
            PG8_WAIT_V(8); PG8_WAIT_L(0); PG8_BAR; PG8_MMA(0, 0, At, B0); PG8_MMA(0, 1, At, B1); PG8_BAR; PG8_SCHED;
            PG8_LDA(At, 1, 1); PG8_STAGE(PG8_SB(1, 0), b3, voffB); PG8_STAGE(PG8_SB(1, 1), b3 + hstep, voffB); PG8_STAGE(PG8_SA(1, 0), a3, voffA);
            PG8_WAIT_V(8); PG8_WAIT_L(0); PG8_BAR; PG8_MMA(1, 0, At, B0); PG8_MMA(1, 1, At, B1); PG8_BAR; PG8_SCHED;
            } else {
            PG8_LDB(B0, 0, 0); PG8_SCHED; PG8_LDA(At, 0, 0); PG8_STAGE(PG8_SA(1, 1), a1 + hstep, voffA);
            PG8_WAIT_L(8); PG8_BAR; PG8_WAIT_L(0); PG8_MMA(0, 0, At, B0); PG8_BAR; PG8_SCHED;
            PG8_LDB(B1, 0, 1); PG8_STAGE(PG8_SB(0, 0), b2, voffB);
            PG8_BAR; PG8_WAIT_L(0); PG8_MMA(0, 1, At, B1); PG8_BAR;
            PG8_LDA(At, 0, 1); PG8_STAGE(PG8_SA(0, 0), a2, voffA);
            PG8_BAR; PG8_WAIT_L(0); PG8_MMA(1, 0, At, B0); PG8_BAR; PG8_SCHED;
            PG8_STAGE(PG8_SB(0, 1), b2 + hstep, voffB);
            PG8_WAIT_V(6); PG8_BAR; PG8_MMA(1, 1, At, B1); PG8_BAR;
            PG8_LDB(B0, 1, 0); PG8_SCHED; PG8_LDA(At, 1, 0); PG8_STAGE(PG8_SA(0, 1), a2 + hstep, voffA);
            PG8_WAIT_L(8); PG8_BAR; PG8_WAIT_L(0); PG8_MMA(0, 0, At, B0); PG8_BAR; PG8_SCHED;
            PG8_LDB(B1, 1, 1); PG8_STAGE(PG8_SB(1, 0), b3, voffB);
            PG8_BAR; PG8_WAIT_L(0); PG8_MMA(0, 1, At, B1); PG8_BAR;
            PG8_LDA(At, 1, 1); PG8_STAGE(PG8_SA(1, 0), a3, voffA);
            PG8_BAR; PG8_WAIT_L(0); PG8_MMA(1, 0, At, B0); PG8_BAR; PG8_SCHED;
            PG8_STAGE(PG8_SB(1, 1), b3 + hstep, voffB);
            PG8_WAIT_V(6); PG8_BAR; PG8_MMA(1, 1, At, B1); PG8_BAR;
            }
        }
        if constexpr (ALIGN_EPI) { if (wr == 0) PG8_BAR; }
        if constexpr (!Epi::AFTER_DRAIN) { const int lz = lane_now();
            E(acc, cur, wr, wc, lz & 15, lz >> 4); S.done(cur); }
        if (!has_next) break;
#pragma unroll
        for (int a = 0; a < 2; ++a)
#pragma unroll
            for (int b = 0; b < 2; ++b)
#pragma unroll
                for (int m = 0; m < 4; ++m)
#pragma unroll
                    for (int n = 0; n < 2; ++n) acc[a][b][m][n] = (f32x4){0.f, 0.f, 0.f, 0.f};
        cur = nxt; cA = nA; cB = nB; ++ui;
        if constexpr (ALIGN_EPI) { if (wr == 1) PG8_BAR; }
    }
    PG8_WAIT_V(0);
    if constexpr (!ALIGN_EPI) { if (wr == 0) PG8_BAR; }
    PG8_BAR;
    if constexpr (Epi::AFTER_DRAIN) { E.fused(acc, cur, wr, wc, fr, fq, lds, wid, lane); S.done(cur); }
#undef PG8_SA
#undef PG8_SB
#undef PG8_STAGE
#undef PG8_LDA
#undef PG8_LDB
#undef PG8_MMA
#undef PG8_WAIT_V
#undef PG8_WAIT_L
#undef PG8_BAR
#undef PG8_SCHED
}
}

#ifndef MK_N_LAUNCHES
#define MK_N_LAUNCHES 1
#endif
static_assert(MK_N_LAUNCHES == 1, "P0 carries a grid barrier inside: one-launch build only");
constexpr int BATCH = 2, SEQ = 8192, D = 4096, DFF = 11008, M = BATCH * SEQ;
constexpr int DH = 2048, NH = 16, HD = 128;
constexpr int NIN = 22528, NUP = 2 * DFF;
constexpr int NPROJ = (7 - NQ8S) * 2048, NGATE = NQ8S * 2048 + 8192;
__host__ __device__ constexpr int win_src_bf(int d) { return bf_seg(d >> 11) * 2048 + (d & 2047); }
__host__ __device__ constexpr int win_src_q8(int d) { return d < NQ8S * 2048 ? q8_seg(d >> 11) * 2048 + (d & 2047) : 14336 + (d - NQ8S * 2048); }
constexpr float NORM_EPS = 1e-6f;
constexpr int NWAVES = 8;
constexpr int NPHASE = 14;

constexpr size_t MiB = 1u << 20;
constexpr size_t WS_CTL = 0, CTL_ZERO_BYTES = 65536;
constexpr size_t WS_CMD1 = 32768, WS_CMD2 = 49152;
constexpr size_t WS_SAH = 1 * MiB + 524288;
constexpr size_t WS_HQ = 1502 * MiB;
constexpr size_t WS_CM1 = 65536, WS_CM2 = WS_CM1 + (size_t)2 * DFF * 4, WS_CMG = WS_CM2 + (size_t)2 * DFF * 4;
constexpr size_t WS_SA1 = 1 * MiB + 262144, WS_SA2 = WS_SA1 + 65536, WS_SAG = WS_SA2 + 65536;
constexpr size_t WS_LB = 1 * MiB;
constexpr size_t WS_DSEG = 1 * MiB + 65536;
constexpr size_t WS_SEND = 2 * MiB;
constexpr size_t WS_W13_1 = 18 * MiB, WS_W2_1 = 190 * MiB, WS_W13_2 = 276 * MiB, WS_W2_2 = 448 * MiB;
constexpr size_t WS_WIN = 534 * MiB, WS_WUA = 710 * MiB, WS_WUB = 726 * MiB, WS_WO = 742 * MiB;
constexpr size_t WS_XN = 774 * MiB;
constexpr size_t WS_YAB = WS_XN;
constexpr size_t WS_Y = 902 * MiB;
constexpr size_t WS_F = WS_Y, WS_QA = WS_Y + 128 * MiB, WS_IA = WS_Y + 192 * MiB, WS_T = WS_Y;
constexpr size_t WS_BIG = 1158 * MiB;
constexpr size_t WS_HID = WS_BIG, WS_GA = WS_BIG, WS_QB = WS_BIG + 64 * MiB, WS_KB = WS_BIG + 128 * MiB, WS_VB = WS_BIG + 192 * MiB, WS_GTA = WS_BIG + 256 * MiB, WS_GTB = WS_BIG + 384 * MiB;
constexpr size_t WS_MX = WS_BIG;
constexpr size_t WS_END = 1674 * MiB;
static_assert(WS_W13_1 + (size_t)NUP * D * 2 == WS_W2_1 && WS_W2_1 + (size_t)D * DFF * 2 == WS_W13_2 && WS_W13_2 + (size_t)NUP * D * 2 == WS_W2_2 && WS_W2_2 + (size_t)D * DFF * 2 == WS_WIN, "ws map (ffn weights)");
static_assert(WS_WIN + (size_t)NIN * D * 2 == WS_WUA && WS_WUA + (size_t)D * DH * 2 == WS_WUB && WS_WUB + (size_t)D * DH * 2 == WS_WO && WS_WO + (size_t)D * D * 2 == WS_XN, "ws map (mixer weights)");
static_assert(WS_XN + (size_t)M * D * 2 == WS_Y && WS_Y + (size_t)M * D * 4 == WS_BIG && WS_HID + (size_t)M * DFF * 2 == WS_HQ && WS_HQ + (size_t)M * DFF == WS_END && WS_GTB + (size_t)M * D * 2 <= WS_HQ + 168 * MiB, "ws map (activations)");
constexpr int CW_BAR = 4096;

constexpr int RING_OFF = 0, RING_BYTES = 131072;
constexpr int LDSCTL_OFF = RING_BYTES, MISC_OFF = LDSCTL_OFF + 320;
constexpr int LDS_BYTES = 147456;

#define GAS __attribute__((address_space(1)))
#define LAS __attribute__((address_space(3)))
typedef unsigned short bf16;
typedef unsigned v4u __attribute__((ext_vector_type(4)));
typedef unsigned v2u __attribute__((ext_vector_type(2)));
typedef float f32x4 __attribute__((ext_vector_type(4)));
typedef float f32x16 __attribute__((ext_vector_type(16)));
typedef short bf16x8 __attribute__((ext_vector_type(8)));
typedef short s16x4 __attribute__((ext_vector_type(4)));
typedef GAS unsigned gu32;
#define RLX_AGENT __ATOMIC_RELAXED, __HIP_MEMORY_SCOPE_AGENT
#define LDS_WAIT() asm volatile("s_waitcnt lgkmcnt(0)" ::: "memory")
#define VM_WAIT() asm volatile("s_waitcnt vmcnt(0)" ::: "memory")
__device__ __forceinline__ unsigned f2bf(float f) { unsigned u = __builtin_bit_cast(unsigned, f); return (u + 0x7fffu + ((u >> 16) & 1u)) >> 16; }
__device__ __forceinline__ unsigned pk2(float lo, float hi) { return pg8::cvt_pk_bf16(lo, hi); }
__device__ __forceinline__ float bflo(unsigned u) { return __uint_as_float(u << 16); }
__device__ __forceinline__ float bfhi(unsigned u) { return __uint_as_float(u & 0xffff0000u); }
#define XB_TMO      128
#define XB_XCNT(j)  (256  + 64 * (j))
#define XB_XSUB(j)  (1280 + 64 * (j))
#define XB_XGEN(j)  (2304 + 64 * (j))
#define XB_TOP      3328
#define XB_TOPGEN   3392
#define XCD_BAR_WORDS 3456
#define XB_SPIN_CAP (1u << 18)

__device__ __forceinline__ unsigned xb_ld(unsigned* p)              { return __hip_atomic_load(p, __ATOMIC_RELAXED, __HIP_MEMORY_SCOPE_AGENT); }
__device__ __forceinline__ unsigned xb_add(unsigned* p, unsigned v) { return __hip_atomic_fetch_add(p, v, __ATOMIC_RELAXED, __HIP_MEMORY_SCOPE_AGENT); }
__device__ __forceinline__ unsigned xb_xcc_id() { return (unsigned)__builtin_amdgcn_s_getreg((3 << 11) | 20) & 0xFu; }
#define XB_SPIN(cond, bar) do { unsigned _sp = 0; while (cond) { __builtin_amdgcn_s_sleep(1); \
    if ((++_sp & 255u) == 0u) { if (xb_ld(&(bar)[XB_TMO])) break; if (_sp > XB_SPIN_CAP) { atomicAdd(&(bar)[XB_TMO], 1u); break; } } } } while (0)

struct XcdBarrier {
    unsigned* bar; unsigned x;
    volatile LAS unsigned* st;
    bool w0;
};

__device__ __forceinline__ XcdBarrier xcd_barrier_post(unsigned* bar, volatile LAS unsigned* st, bool w0) {
    XcdBarrier b; b.bar = bar; b.x = xb_xcc_id(); b.st = st; b.w0 = w0;
    if (w0 && lane_now() == 0) (void)xb_add(&bar[XB_XCNT(b.x)], 1u);
    return b;
}
__device__ __forceinline__ void xcd_barrier_complete(unsigned* bar, unsigned x, unsigned& nloc, unsigned& nx) {
    const unsigned G = gridDim.x * gridDim.y * gridDim.z;
    unsigned sum, cnt, mine, sp = 0u;
    for (;;) {
        sum = 0u; cnt = 0u; mine = 0u;
#pragma unroll
        for (unsigned j = 0; j < 16; ++j) { const unsigned c = xb_ld(&bar[XB_XCNT(j)]); sum += c; cnt += (c > 0u) ? 1u : 0u; mine = (j == x) ? c : mine; }
        if (sum == G) break;
        __builtin_amdgcn_s_sleep(1);
        if ((++sp & 255u) == 0u) { if (xb_ld(&bar[XB_TMO])) break; if (sp > XB_SPIN_CAP) { atomicAdd(&bar[XB_TMO], 1u); break; } }
    }
    nloc = mine > 0u ? mine : 1u; nx = cnt > 0u ? cnt : 1u;
}

__device__ __forceinline__ void xcd_barrier(const XcdBarrier& b) {
    asm volatile("s_waitcnt vmcnt(0)" ::: "memory");
    __syncthreads();
    if (b.w0 && lane_now() == 0) {
        unsigned* bar = b.bar;
        __builtin_amdgcn_s_waitcnt(0);
        unsigned nloc = b.st[0], nx = b.st[1];
        if (nloc == 0u) { xcd_barrier_complete(bar, b.x, nloc, nx); b.st[0] = nloc; b.st[1] = nx; }
        const unsigned old = xb_add(&bar[XB_XSUB(b.x)], 1u);
        const unsigned gen = old / nloc;
        if (old + 1u == (gen + 1u) * nloc) {
            __builtin_amdgcn_fence(__ATOMIC_RELEASE, "agent");
            asm volatile("s_waitcnt vmcnt(0)" ::: "memory");
            const unsigned og = xb_add(&bar[XB_TOP], 1u);
            const unsigned tg = og / nx;
            if (og + 1u == (tg + 1u) * nx) xb_add(&bar[XB_TOPGEN], 1u);
            else XB_SPIN(xb_ld(&bar[XB_TOPGEN]) == tg, bar);
            __builtin_amdgcn_fence(__ATOMIC_ACQUIRE, "agent");
            xb_add(&bar[XB_XGEN(b.x)], 1u);
            asm volatile("s_waitcnt vmcnt(0)" ::: "memory");
        } else {
            XB_SPIN(xb_ld(&bar[XB_XGEN(b.x)]) == gen, bar);
            __builtin_amdgcn_fence(__ATOMIC_ACQUIRE, "agent");
            asm volatile("s_waitcnt vmcnt(0)" ::: "memory");
        }
    }
    __syncthreads();
}


__device__ __forceinline__ float wave_sum(float v) {
#pragma unroll
    for (int o = 1; o < 64; o <<= 1) v += __shfl_xor(v, o);
    return v;
}
__device__ __forceinline__ void tr_item(const float* __restrict__ W, int K, int N, bf16* __restrict__ WT, int k0, int n0, int dst_row0, LAS float* scr, int lane, int kd0 = -1) {
    if (kd0 < 0) kd0 = k0;
#pragma unroll 8
    for (int i = 0; i < 32; ++i) { const int kk = 2 * i + (lane >> 5); scr[kk * 33 + (lane & 31)] = W[(size_t)(k0 + kk) * N + n0 + (lane & 31)]; }
    LDS_WAIT(); asm volatile("" ::: "memory");
    const int c = lane & 7;
#pragma unroll
    for (int j = 0; j < 4; ++j) { const int n = (lane >> 3) + 8 * j; const LAS float* s = scr + (8 * c) * 33 + n;
        v4u o; o.x = pk2(s[0 * 33], s[1 * 33]); o.y = pk2(s[2 * 33], s[3 * 33]); o.z = pk2(s[4 * 33], s[5 * 33]); o.w = pk2(s[6 * 33], s[7 * 33]);
        *(GAS v4u*)(WT + (size_t)(dst_row0 + n) * K + kd0 + 8 * c) = o; }
    LDS_WAIT(); asm volatile("" ::: "memory");
}
__device__ __forceinline__ void tr_plain(const float* W, int K, int N, bf16* WT, int r, LAS float* scr, int lane) {
    const int nblk = N / 32, kb = r / nblk, nb = r % nblk; tr_item(W, K, N, WT, 64 * kb, 32 * nb, 32 * nb, scr, lane);
}
__device__ __forceinline__ void tr_glu(const float* W, bf16* WT, int half, int r, LAS float* scr, int lane) {
    const int nblk = DFF / 32, kb = r / nblk, nb = r % nblk, n0 = 32 * nb; tr_item(W, D, DFF, WT, 64 * kb, n0, 256 * (n0 >> 7) + (n0 & 127) + 128 * half, scr, lane);
}
__device__ __forceinline__ float wave_max(float v) {
#pragma unroll
    for (int o = 1; o < 64; o <<= 1) v = fmaxf(v, __shfl_xor(v, o));
    return v;
}
__device__ __forceinline__ int q8(float x) { return (int)__builtin_rintf(x); }
__device__ __forceinline__ unsigned pk4_i8(float a, float b, float c, float d) {
    const float MG = 12582912.0f;
    const unsigned ua = __float_as_uint(a + MG), ub = __float_as_uint(b + MG), uc = __float_as_uint(c + MG), ud = __float_as_uint(d + MG);
    return __builtin_amdgcn_perm(ub, ua, 0x0c0c0400u) | (__builtin_amdgcn_perm(ud, uc, 0x0c0c0400u) << 16);
}
__device__ __forceinline__ void wg_q8_item(const float* __restrict__ W, int N, int n0, unsigned char* __restrict__ WT8, int dst_row0, float* CM, LAS unsigned char* lds, int wave, int lane) {
    LAS float* scr = (LAS float*)(lds + wave * 16384);
    LAS float* cmL = (LAS float*)(lds + 12288);
    LAS float* cfin = cmL + 256;
    {   f32x4 mx = (f32x4){0.f, 0.f, 0.f, 0.f};
        const float* src = W + (size_t)(512 * wave + (lane >> 3)) * N + n0 + 4 * (lane & 7);
#pragma unroll 8
        for (int r = 0; r < 64; ++r) { const f32x4 v = *(const GAS f32x4*)(src + (size_t)(8 * r) * N);
            mx.x = fmaxf(mx.x, fabsf(v.x)); mx.y = fmaxf(mx.y, fabsf(v.y)); mx.z = fmaxf(mx.z, fabsf(v.z)); mx.w = fmaxf(mx.w, fabsf(v.w)); }
#pragma unroll
        for (int o = 8; o < 64; o <<= 1) { mx.x = fmaxf(mx.x, __shfl_xor(mx.x, o)); mx.y = fmaxf(mx.y, __shfl_xor(mx.y, o)); mx.z = fmaxf(mx.z, __shfl_xor(mx.z, o)); mx.w = fmaxf(mx.w, __shfl_xor(mx.w, o)); }
        if (lane < 8) *(LAS f32x4*)(cmL + wave * 32 + 4 * lane) = mx; }
    __syncthreads();
    if (wave == 0 && lane < 32) { float c = cmL[lane];
#pragma unroll
        for (int w = 1; w < 8; ++w) c = fmaxf(c, cmL[w * 32 + lane]);
        cfin[lane] = c; CM[dst_row0 + lane] = c; }
    __syncthreads();
    const int c8 = lane & 7;
    float inv[4];
#pragma unroll
    for (int j = 0; j < 4; ++j) { const float cmv = cfin[(lane >> 3) + 8 * j]; inv[j] = cmv > 0.f ? 127.0f / cmv : 0.f; }
    for (int ch = 0; ch < 8; ++ch) {
        const int k0 = 512 * wave + 64 * ch;
#pragma unroll 8
        for (int i = 0; i < 32; ++i) { const int kk = 2 * i + (lane >> 5); scr[kk * 33 + (lane & 31)] = W[(size_t)(k0 + kk) * N + n0 + (lane & 31)]; }
        LDS_WAIT(); asm volatile("" ::: "memory");
#pragma unroll
        for (int j = 0; j < 4; ++j) { const int n = (lane >> 3) + 8 * j; const LAS float* sp = scr + (8 * c8) * 33 + n;
            v2u o; o.x = pk4_i8(sp[0 * 33] * inv[j], sp[1 * 33] * inv[j], sp[2 * 33] * inv[j], sp[3 * 33] * inv[j]); o.y = pk4_i8(sp[4 * 33] * inv[j], sp[5 * 33] * inv[j], sp[6 * 33] * inv[j], sp[7 * 33] * inv[j]);
            *(GAS v2u*)(WT8 + (size_t)(dst_row0 + n) * 4096 + k0 + 8 * c8) = o; }
        LDS_WAIT(); asm volatile("" ::: "memory");
    }
    __syncthreads();
}
template <bool QUANT>
__device__ __forceinline__ void w2_had_item(const float* __restrict__ W, unsigned char* __restrict__ WT8, unsigned* CMX, int r, LAS float* scr, int lane, int nb0 = 0, int nblk = D / 32) {
    const int kb = r / nblk, nb = nb0 + r % nblk, k0 = 64 * kb, n0 = 32 * nb;
    float inv[4];
    if constexpr (QUANT) {
#pragma unroll
        for (int j = 0; j < 4; ++j) { const float cmv = __uint_as_float(CMX[n0 + (lane >> 3) + 8 * j]); inv[j] = cmv > 0.f ? 127.0f / cmv : 0.f; }
    }
#pragma unroll 8
    for (int i = 0; i < 32; ++i) { const int kk = 2 * i + (lane >> 5); scr[kk * 33 + (lane & 31)] = W[(size_t)(k0 + kk) * D + n0 + (lane & 31)]; }
    LDS_WAIT(); asm volatile("" ::: "memory");
    const int c = lane & 7;
#pragma unroll
    for (int j = 0; j < 4; ++j) { const int n = (lane >> 3) + 8 * j; const LAS float* sp = scr + (8 * c) * 33 + n;
        float v[8];
#pragma unroll
        for (int i = 0; i < 8; ++i) v[i] = sp[i * 33];
        wht8(v); wht_q<0xB1>(v, 1, lane); wht_q<0x4E>(v, 2, lane);
        if constexpr (!QUANT) {
            float mx = fmaxf(fmaxf(fmaxf(fabsf(v[0]), fabsf(v[1])), fmaxf(fabsf(v[2]), fabsf(v[3]))), fmaxf(fmaxf(fabsf(v[4]), fabsf(v[5])), fmaxf(fabsf(v[6]), fabsf(v[7]))));
            mx = fmaxf(mx, dpp_f<0xB1>(mx)); mx = fmaxf(mx, dpp_f<0x4E>(mx)); mx = fmaxf(mx, dpp_f<0x104>(mx));
            if (c == 0) (void)__hip_atomic_fetch_max(CMX + n0 + n, __float_as_uint(mx), RLX_AGENT);
        } else {
            const float iv = inv[j];
            v2u o; o.x = pk4_i8(v[0] * iv, v[1] * iv, v[2] * iv, v[3] * iv); o.y = pk4_i8(v[4] * iv, v[5] * iv, v[6] * iv, v[7] * iv);
            *(GAS v2u*)(WT8 + (size_t)(n0 + n) * DFF + k0 + 8 * c) = o; }
    }
    LDS_WAIT(); asm volatile("" ::: "memory");
}
template <bool QUANT>
__device__ __forceinline__ void w2_had_stream(const float* __restrict__ W, unsigned char* __restrict__ WT8, unsigned* CMX, int it0, int step, int nit, LAS float* scr, int lane, int nblk) {
    float v[32]; float cmn[4] = {0.f, 0.f, 0.f, 0.f};
    if (it0 < nit) { const int kb = it0 / nblk, nb = it0 % nblk; const float* src = W + (size_t)(64 * kb + (lane >> 5)) * D + 32 * nb + (lane & 31);
#pragma unroll
        for (int i = 0; i < 32; ++i) v[i] = src[(size_t)(2 * i) * D];
        if constexpr (QUANT) {
#pragma unroll
            for (int j = 0; j < 4; ++j) cmn[j] = __uint_as_float(CMX[32 * nb + (lane >> 3) + 8 * j]); } }
    for (int it = it0; it < nit; it += step) {
        const int kb = it / nblk, nb = it % nblk, k0 = 64 * kb, n0 = 32 * nb;
#pragma unroll
        for (int i = 0; i < 32; ++i) scr[(2 * i + (lane >> 5)) * 33 + (lane & 31)] = v[i];
        float inv[4];
#pragma unroll
        for (int j = 0; j < 4; ++j) inv[j] = cmn[j] > 0.f ? 127.0f / cmn[j] : 0.f;
        const int nx = it + step;
        if (nx < nit) { const int kb2 = nx / nblk, nb2 = nx % nblk; const float* src = W + (size_t)(64 * kb2 + (lane >> 5)) * D + 32 * nb2 + (lane & 31);
#pragma unroll
            for (int i = 0; i < 32; ++i) v[i] = src[(size_t)(2 * i) * D];
            if constexpr (QUANT) {
#pragma unroll
                for (int j = 0; j < 4; ++j) cmn[j] = __uint_as_float(CMX[32 * nb2 + (lane >> 3) + 8 * j]); } }
        LDS_WAIT(); asm volatile("" ::: "memory");
        const int c = lane & 7;
#pragma unroll
        for (int j = 0; j < 4; ++j) { const int n = (lane >> 3) + 8 * j; const LAS float* sp = scr + (8 * c) * 33 + n;
            float t[8];
#pragma unroll
            for (int i = 0; i < 8; ++i) t[i] = sp[i * 33];
            wht8(t); wht_q<0xB1>(t, 1, lane); wht_q<0x4E>(t, 2, lane);
            if constexpr (!QUANT) {
                float mx = fmaxf(fmaxf(fmaxf(fabsf(t[0]), fabsf(t[1])), fmaxf(fabsf(t[2]), fabsf(t[3]))), fmaxf(fmaxf(fabsf(t[4]), fabsf(t[5])), fmaxf(fabsf(t[6]), fabsf(t[7]))));
                mx = fmaxf(mx, dpp_f<0xB1>(mx)); mx = fmaxf(mx, dpp_f<0x4E>(mx)); mx = fmaxf(mx, dpp_f<0x104>(mx));
                if (c == 0) (void)__hip_atomic_fetch_max(CMX + n0 + n, __float_as_uint(mx), RLX_AGENT);
            } else {
                const float iv = inv[j];
                v2u o; o.x = pk4_i8(t[0] * iv, t[1] * iv, t[2] * iv, t[3] * iv); o.y = pk4_i8(t[4] * iv, t[5] * iv, t[6] * iv, t[7] * iv);
                *(GAS v2u*)(WT8 + (size_t)(n0 + n) * DFF + k0 + 8 * c) = o; }
        }
        LDS_WAIT(); asm volatile("" ::: "memory");
    }
}
__device__ __forceinline__ void hid_row_to_q8(const bf16* hrow, unsigned char* qrow, float* sa, int lane) {
    const GAS v2u* h4 = (const GAS v2u*)hrow + lane; GAS unsigned* o4 = (GAS unsigned*)qrow + lane;
    v2u hv[43];
#pragma unroll
    for (int i = 0; i < 43; ++i) hv[i] = h4[64 * i];
    float am = 0.f;
#pragma unroll
    for (int i = 0; i < 43; ++i) am = fmaxf(fmaxf(am, fmaxf(fabsf(bflo(hv[i].x)), fabsf(bfhi(hv[i].x)))), fmaxf(fabsf(bflo(hv[i].y)), fabsf(bfhi(hv[i].y))));
    am = wave_max(am); const float inv = am > 0.f ? 127.0f / am : 0.f;
    if (lane == 0) *sa = am * (1.0f / 127.0f);
#pragma unroll
    for (int i = 0; i < 43; ++i) { const v2u w = hv[i]; o4[64 * i] = pk4_i8(bflo(w.x) * inv, bfhi(w.x) * inv, bflo(w.y) * inv, bfhi(w.y) * inv); }
}
__device__ __forceinline__ void wg_q8_item_h(const float* __restrict__ W, int N, int n0, unsigned char* __restrict__ WT8, int dst_row0, float* CM, LAS unsigned char* lds, int wave, int lane) {
    LAS float* cmL = (LAS float*)(lds + MISC_OFF + 1024);
    LAS float* cfin = cmL + 256;
    v2u rp[8][4];
    {   f32x4 mx = (f32x4){0.f, 0.f, 0.f, 0.f};
        const int g = lane >> 3, q = lane & 7;
        const float* src = W + (size_t)(512 * wave + 4 * g) * N + n0 + 4 * q;
#pragma unroll 4
        for (int it = 0; it < 8; ++it) {
            f32x4 v[4];
#pragma unroll
            for (int j = 0; j < 4; ++j) v[j] = *(const GAS f32x4*)(src + (size_t)(32 * it + j) * N);
#pragma unroll
            for (int j = 0; j < 4; ++j) { mx.x = fmaxf(mx.x, fabsf(v[j].x)); mx.y = fmaxf(mx.y, fabsf(v[j].y)); mx.z = fmaxf(mx.z, fabsf(v[j].z)); mx.w = fmaxf(mx.w, fabsf(v[j].w)); }
            const int gr = (64 * wave + 8 * it + g) ^ (q << 1);
#pragma unroll
            for (int c = 0; c < 4; ++c) { v2u o; o.x = pg8::cvt_pk_bf16(v[0][c], v[1][c]); o.y = pg8::cvt_pk_bf16(v[2][c], v[3][c]); *(LAS v2u*)(lds + (4 * q + c) * 4096 + gr * 8) = o; }
        }
#pragma unroll
        for (int it = 0; it < 8; ++it) {
            f32x4 v[4];
#pragma unroll
            for (int j = 0; j < 4; ++j) v[j] = *(const GAS f32x4*)(src + (size_t)(256 + 32 * it + j) * N);
#pragma unroll
            for (int j = 0; j < 4; ++j) { mx.x = fmaxf(mx.x, fabsf(v[j].x)); mx.y = fmaxf(mx.y, fabsf(v[j].y)); mx.z = fmaxf(mx.z, fabsf(v[j].z)); mx.w = fmaxf(mx.w, fabsf(v[j].w)); }
#pragma unroll
            for (int c = 0; c < 4; ++c) { rp[it][c].x = pg8::cvt_pk_bf16(v[0][c], v[1][c]); rp[it][c].y = pg8::cvt_pk_bf16(v[2][c], v[3][c]); }
        }
#pragma unroll
        for (int o = 8; o < 64; o <<= 1) { mx.x = fmaxf(mx.x, __shfl_xor(mx.x, o)); mx.y = fmaxf(mx.y, __shfl_xor(mx.y, o)); mx.z = fmaxf(mx.z, __shfl_xor(mx.z, o)); mx.w = fmaxf(mx.w, __shfl_xor(mx.w, o)); }
        if (lane < 8) *(LAS f32x4*)(cmL + wave * 32 + 4 * lane) = mx; }
    __syncthreads();
    if (wave == 0 && lane < 32) { float c = cmL[lane];
#pragma unroll
        for (int w = 1; w < 8; ++w) c = fmaxf(c, cmL[w * 32 + lane]);
        c = bflo(pg8::cvt_pk_bf16(c, c));
        cfin[lane] = c; CM[dst_row0 + lane] = c; }
    __syncthreads();
#pragma unroll
    for (int h = 0; h < 4; ++h) { const int n = 4 * wave + h; const float cmv = cfin[n]; const float inv = cmv > 0.f ? 127.0f / cmv : 0.f;
        const LAS unsigned char* rowp = lds + n * 4096; const int sw = n >> 2;
#pragma unroll
        for (int i = 0; i < 4; ++i) { const int y = lane + 64 * i; const v4u w = *(const LAS v4u*)(rowp + ((y ^ sw) << 4));
            v2u o; o.x = pk4_i8(bflo(w.x) * inv, bfhi(w.x) * inv, bflo(w.y) * inv, bfhi(w.y) * inv); o.y = pk4_i8(bflo(w.z) * inv, bfhi(w.z) * inv, bflo(w.w) * inv, bfhi(w.w) * inv);
            *(GAS v2u*)(WT8 + (size_t)(dst_row0 + n) * 4096 + 512 * (y >> 5) + 8 * (y & 31)) = o; } }
    {   const int g = lane >> 3, q = lane & 7;
#pragma unroll
        for (int c = 0; c < 4; ++c) { const float cmv = cfin[4 * q + c]; const float iv = cmv > 0.f ? 127.0f / cmv : 0.f;
            unsigned char* rowp = WT8 + (size_t)(dst_row0 + 4 * q + c) * 4096 + 512 * wave + 256 + 4 * g;
#pragma unroll
            for (int it = 0; it < 8; ++it) *(GAS unsigned*)(rowp + 32 * it) = pk4_i8(bflo(rp[it][c].x) * iv, bfhi(rp[it][c].x) * iv, bflo(rp[it][c].y) * iv, bfhi(rp[it][c].y) * iv); } }
    __syncthreads();
}
__device__ __forceinline__ void rms_row_to_q8(const float* xrow, const float* g, unsigned char* qrow, float* sa, int lane, bf16* xbrow = nullptr) {
    asm volatile("" : "+s"(g));
    const GAS f32x4* xr = (const GAS f32x4*)xrow + lane; const GAS f32x4* gr = (const GAS f32x4*)g + lane;
    f32x4 v[16]; float s = 0.f;
#pragma unroll
    for (int j = 0; j < 16; ++j) { v[j] = xr[64 * j]; s += (v[j].x * v[j].x + v[j].y * v[j].y) + (v[j].z * v[j].z + v[j].w * v[j].w); }
    if (xbrow != nullptr) { GAS v2u* xb = (GAS v2u*)xbrow + lane;
#pragma unroll
        for (int j = 0; j < 16; ++j) { v2u o; o.x = pk2(v[j].x, v[j].y); o.y = pk2(v[j].z, v[j].w); xb[64 * j] = o; } }
    const float r = 1.0f / sqrtf(wave_sum(s) * (1.f / D) + NORM_EPS);
    float am = 0.f;
#pragma unroll
    for (int j = 0; j < 16; ++j) { const f32x4 gg = gr[64 * j]; v[j].x *= r * gg.x; v[j].y *= r * gg.y; v[j].z *= r * gg.z; v[j].w *= r * gg.w;
        am = fmaxf(am, fmaxf(fmaxf(fabsf(v[j].x), fabsf(v[j].y)), fmaxf(fabsf(v[j].z), fabsf(v[j].w)))); }
    am = wave_max(am); const float inv = am > 0.f ? 127.0f / am : 0.f;
    if (lane == 0) *sa = am * (1.0f / 127.0f);
    GAS unsigned* o4 = (GAS unsigned*)qrow + lane;
#pragma unroll
    for (int j = 0; j < 16; ++j) o4[64 * j] = pk4_i8(v[j].x * inv, v[j].y * inv, v[j].z * inv, v[j].w * inv);
}
__device__ __forceinline__ void rms_row_to_bf16(const float* xrow, const float* __restrict__ g, bf16* orow, int lane) {
    const GAS f32x4* xr = (const GAS f32x4*)xrow + lane; const GAS f32x4* gr = (const GAS f32x4*)g + lane;
    f32x4 v[16]; float s = 0.f;
#pragma unroll
    for (int j = 0; j < 16; ++j) { v[j] = xr[64 * j]; s += (v[j].x * v[j].x + v[j].y * v[j].y) + (v[j].z * v[j].z + v[j].w * v[j].w); }
    const float r = 1.0f / sqrtf(wave_sum(s) * (1.f / D) + NORM_EPS);
    GAS v2u* o8 = (GAS v2u*)orow + lane;
#pragma unroll
    for (int j = 0; j < 16; ++j) { const f32x4 gg = gr[64 * j]; v2u o; o.x = pk2(v[j].x * r * gg.x, v[j].y * r * gg.y); o.y = pk2(v[j].z * r * gg.z, v[j].w * r * gg.w); o8[64 * j] = o; }
}
template <bool HN, bool XI_BF, bool XO_BF, bool HB = true, bool H8 = false> __device__ __forceinline__ void post_row(const bf16* yrow, const void* xi, void* xo, const float* gpost, float wgt, const float* gpre, bf16* hrow, int lane, unsigned char* h8row = nullptr, float* sa = nullptr) {
    asm volatile("" : "+s"(gpost), "+s"(gpre));
    const GAS v4u* yr = (const GAS v4u*)yrow + lane;
    const GAS f32x4* gp = (const GAS f32x4*)gpost + 2 * lane;
    f32x4 v[8][2]; float s = 0.f;
    v4u xb[8]; f32x4 xf[8][2];
#pragma unroll
    for (int j = 0; j < 8; ++j) { if (XI_BF) xb[j] = ((const GAS v4u*)xi + lane)[64 * j]; else { xf[j][0] = ((const GAS f32x4*)xi + 2 * lane)[128 * j]; xf[j][1] = ((const GAS f32x4*)xi + 2 * lane)[128 * j + 1]; } }
#pragma unroll
    for (int j = 0; j < 8; ++j) { const v4u w = yr[64 * j]; v[j][0] = (f32x4){bflo(w.x), bfhi(w.x), bflo(w.y), bfhi(w.y)}; v[j][1] = (f32x4){bflo(w.z), bfhi(w.z), bflo(w.w), bfhi(w.w)};
#pragma unroll
        for (int e = 0; e < 2; ++e) s += (v[j][e].x * v[j][e].x + v[j][e].y * v[j][e].y) + (v[j][e].z * v[j][e].z + v[j][e].w * v[j][e].w); }
    const float r = wgt / sqrtf(wave_sum(s) * (1.f / D) + NORM_EPS);
    float s2 = 0.f;
#pragma unroll
    for (int j = 0; j < 8; ++j) {
        f32x4 xx[2];
        if (XI_BF) { const v4u w = xb[j]; xx[0] = (f32x4){bflo(w.x), bfhi(w.x), bflo(w.y), bfhi(w.y)}; xx[1] = (f32x4){bflo(w.z), bfhi(w.z), bflo(w.w), bfhi(w.w)}; }
        else { xx[0] = xf[j][0]; xx[1] = xf[j][1]; }
#pragma unroll
        for (int e = 0; e < 2; ++e) { const f32x4 gg = gp[128 * j + e];
            v[j][e].x = xx[e].x + v[j][e].x * r * gg.x; v[j][e].y = xx[e].y + v[j][e].y * r * gg.y; v[j][e].z = xx[e].z + v[j][e].z * r * gg.z; v[j][e].w = xx[e].w + v[j][e].w * r * gg.w;
            s2 += (v[j][e].x * v[j][e].x + v[j][e].y * v[j][e].y) + (v[j][e].z * v[j][e].z + v[j][e].w * v[j][e].w); }
        if (XO_BF) { v4u o; o.x = pk2(v[j][0].x, v[j][0].y); o.y = pk2(v[j][0].z, v[j][0].w); o.z = pk2(v[j][1].x, v[j][1].y); o.w = pk2(v[j][1].z, v[j][1].w); ((GAS v4u*)xo + lane)[64 * j] = o; }
        else { ((GAS f32x4*)xo + 2 * lane)[128 * j] = v[j][0]; ((GAS f32x4*)xo + 2 * lane)[128 * j + 1] = v[j][1]; }
    }
    if (HN) {
        const float r2 = 1.0f / sqrtf(wave_sum(s2) * (1.f / D) + NORM_EPS);
        const GAS f32x4* gq = (const GAS f32x4*)gpre + 2 * lane; float am = 0.f;
#pragma unroll
        for (int j = 0; j < 8; ++j)
#pragma unroll
            for (int e = 0; e < 2; ++e) { const f32x4 gg = gq[128 * j + e]; v[j][e].x *= r2 * gg.x; v[j][e].y *= r2 * gg.y; v[j][e].z *= r2 * gg.z; v[j][e].w *= r2 * gg.w;
                if (H8) am = fmaxf(am, fmaxf(fmaxf(fabsf(v[j][e].x), fabsf(v[j][e].y)), fmaxf(fabsf(v[j][e].z), fabsf(v[j][e].w)))); }
        if (HB) { GAS v4u* o16 = (GAS v4u*)hrow + lane;
#pragma unroll
            for (int j = 0; j < 8; ++j) { v4u o; o.x = pk2(v[j][0].x, v[j][0].y); o.y = pk2(v[j][0].z, v[j][0].w); o.z = pk2(v[j][1].x, v[j][1].y); o.w = pk2(v[j][1].z, v[j][1].w); o16[64 * j] = o; } }
        if (H8) { am = wave_max(am); const float inv = am > 0.f ? 127.0f / am : 0.f;
            if (lane == 0) *sa = am * (1.0f / 127.0f);
#pragma unroll
            for (int j = 0; j < 8; ++j) { v2u q; q.x = pk4_i8(v[j][0].x * inv, v[j][0].y * inv, v[j][0].z * inv, v[j][0].w * inv); q.y = pk4_i8(v[j][1].x * inv, v[j][1].y * inv, v[j][1].z * inv, v[j][1].w * inv);
                ((GAS v2u*)h8row + lane)[64 * j] = q; } }
    }
}

constexpr int HG_NSEG = 8, HG_SEGLEN = SEQ / HG_NSEG, HG_TB = 32;
struct HgT { const float* F; const bf16* QA; const bf16* IA; const bf16* GA; const float* normg; float* SEND; float* DSEG; bf16* YA; };
constexpr int AL_K = 0, AL_V = 34816, AL_BT = 69632, A_TILE = 17408, A_RS = 272;
struct AtT { const bf16* QB; const bf16* KB; const bf16* VB; const float* relb; bf16* YB; };
typedef float f32x2_t __attribute__((ext_vector_type(2)));
typedef __bf16 bf16x2_t __attribute__((ext_vector_type(2)));
__device__ __forceinline__ unsigned cvtpk_s(float lo, float hi) { f32x2_t v = {lo, hi}; bf16x2_t b = __builtin_convertvector(v, bf16x2_t); return __builtin_bit_cast(unsigned, b); }
__device__ __forceinline__ bf16x8 pack8(float a0, float a1, float a2, float a3, float a4, float a5, float a6, float a7) {
    v4u w; w.x = cvtpk_s(a0, a1); w.y = cvtpk_s(a2, a3); w.z = cvtpk_s(a4, a5); w.w = cvtpk_s(a6, a7); return __builtin_bit_cast(bf16x8, w);
}
__device__ __forceinline__ s16x4 vtr(const LAS unsigned char* p) { return __builtin_bit_cast(s16x4, __builtin_amdgcn_ds_read_tr16_b64_v4i16((LAS s16x4*)p)); }
__device__ __forceinline__ void attn_item(const AtT& T, LAS unsigned char* lds, int bh, int ib, int tid) {
    const int w = __builtin_amdgcn_readfirstlane(tid >> 6), lane = tid & 63, l31 = lane & 31, hh = lane >> 5;
    const int b = bh >> 4, h = bh & 15, c0 = 4 * ib, j = w >> 1;
    const size_t mq = (size_t)b * SEQ + 256 * ib + 32 * w + l31;
    LAS float* bt = (LAS float*)(lds + AL_BT);
    for (int i = tid; i < 513; i += 512) bt[i] = T.relb[h * 513 + i] * 1.4426950408889634f;
    bf16x8 qf[8];
#pragma unroll
    for (int ks = 0; ks < 8; ++ks) qf[ks] = *(const GAS bf16x8*)(T.QB + mq * DH + h * HD + 16 * ks + 8 * hh);
    f32x16 O[4];
#pragma unroll
    for (int d = 0; d < 4; ++d)
#pragma unroll
        for (int r = 0; r < 16; ++r) O[d][r] = 0.f;
    float m_run = -1e30f, l_run = 0.f;
    const int tt_lo = (8 - c0) > 0 ? (8 - c0) : 0;
    const int lr = tid >> 4, lc = tid & 15;
    v4u kreg[2], vreg[2];
#define AT_LOAD(tt) do { const size_t mk = (size_t)b * SEQ + (size_t)(64 * (c0 - 8 + (tt))); _Pragma("unroll") for (int i = 0; i < 2; ++i) { const size_t o = (mk + lr + 32 * i) * DH + h * HD + 8 * lc; \
        kreg[i] = *(const GAS v4u*)(T.KB + o); vreg[i] = *(const GAS v4u*)(T.VB + o); } } while (0)
#define AT_STORE(buf) do { _Pragma("unroll") for (int i = 0; i < 2; ++i) { const int o = (buf) * A_TILE + (lr + 32 * i) * A_RS + lc * 16; \
        *(LAS v4u*)(lds + AL_K + o) = kreg[i]; *(LAS v4u*)(lds + AL_V + o) = vreg[i]; } } while (0)
    AT_LOAD(tt_lo); AT_STORE(tt_lo & 1);
    __syncthreads();
    for (int tt = tt_lo; tt < 12; ++tt) {
        if (tt + 1 < 12) AT_LOAD(tt + 1);
        if (j <= tt && tt <= j + 8) {
            const int dist = j + 8 - tt;
            const LAS unsigned char* Kt = lds + AL_K + (tt & 1) * A_TILE; const LAS unsigned char* Vt = lds + AL_V + (tt & 1) * A_TILE;
            f32x16 s0, s1;
#pragma unroll
            for (int r = 0; r < 16; ++r) { s0[r] = 0.f; s1[r] = 0.f; }
#pragma unroll
            for (int ks = 0; ks < 8; ++ks) {
                const bf16x8 a0 = *(const LAS bf16x8*)(Kt + l31 * A_RS + (16 * ks + 8 * hh) * 2);
                const bf16x8 a1 = *(const LAS bf16x8*)(Kt + (32 + l31) * A_RS + (16 * ks + 8 * hh) * 2);
                s0 = __builtin_amdgcn_mfma_f32_32x32x16_bf16(a0, qf[ks], s0, 0, 0, 0);
                s1 = __builtin_amdgcn_mfma_f32_32x32x16_bf16(a1, qf[ks], s1, 0, 0, 0);
            }
            const int qi = 32 * (w & 1) + l31; const int relb0 = 64 * dist + qi - 4 * hh;
            float mx = -1e30f;
#pragma unroll
            for (int r = 0; r < 16; ++r) { const int ki = 8 * (r >> 2) + (r & 3); int i0 = relb0 - ki; int i1 = i0 - 32; i0 = (i0 > 256 ? 256 : i0) + 256; i1 = (i1 > 256 ? 256 : i1) + 256;
                s0[r] += bt[i0]; s1[r] += bt[i1]; mx = fmaxf(mx, fmaxf(s0[r], s1[r])); }
            mx = fmaxf(mx, __shfl_xor(mx, 32));
            const float m_new = fmaxf(m_run, mx); const float alpha = __builtin_amdgcn_exp2f(m_run - m_new); m_run = m_new;
            float ps = 0.f;
#pragma unroll
            for (int r = 0; r < 16; ++r) { s0[r] = __builtin_amdgcn_exp2f(s0[r] - m_new); s1[r] = __builtin_amdgcn_exp2f(s1[r] - m_new); ps += s0[r] + s1[r]; }
            l_run = l_run * alpha + ps;
#pragma unroll
            for (int d = 0; d < 4; ++d)
#pragma unroll
                for (int r = 0; r < 16; ++r) O[d][r] *= alpha;
            const int g = lane >> 4, tq = (lane & 15) >> 2, tp = lane & 3;
            const LAS unsigned char* vbase = Vt + (4 * hh + tq) * A_RS + (16 * (g & 1) + 4 * tp) * 2;
#pragma unroll
            for (int blk = 0; blk < 2; ++blk)
#pragma unroll
                for (int s = 0; s < 2; ++s) {
                    const bf16x8 pb = blk == 0 ? pack8(s0[8 * s + 0], s0[8 * s + 1], s0[8 * s + 2], s0[8 * s + 3], s0[8 * s + 4], s0[8 * s + 5], s0[8 * s + 6], s0[8 * s + 7])
                                               : pack8(s1[8 * s + 0], s1[8 * s + 1], s1[8 * s + 2], s1[8 * s + 3], s1[8 * s + 4], s1[8 * s + 5], s1[8 * s + 6], s1[8 * s + 7]);
#pragma unroll
                    for (int d = 0; d < 4; ++d) {
                        const LAS unsigned char* p = vbase + (32 * blk + 16 * s) * A_RS + 64 * d;
                        const s16x4 lo = vtr(p), hi = vtr(p + 8 * A_RS);
                        const bf16x8 va = (bf16x8){lo[0], lo[1], lo[2], lo[3], hi[0], hi[1], hi[2], hi[3]};
                        O[d] = __builtin_amdgcn_mfma_f32_32x32x16_bf16(va, pb, O[d], 0, 0, 0);
                    }
                }
        }
        if (tt + 1 < 12) AT_STORE((tt + 1) & 1);
        __syncthreads();
    }
#undef AT_LOAD
#undef AT_STORE
    const float lt = l_run + __shfl_xor(l_run, 32); const float inv = 1.0f / lt;
#pragma unroll
    for (int d = 0; d < 4; ++d)
#pragma unroll
        for (int rq = 0; rq < 4; ++rq) { v2u o; o.x = pk2(O[d][4 * rq] * inv, O[d][4 * rq + 1] * inv); o.y = pk2(O[d][4 * rq + 2] * inv, O[d][4 * rq + 3] * inv);
            *(GAS v2u*)(T.YB + mq * D + h * HD + 32 * d + 8 * rq + 4 * hh) = o; }
}

constexpr int H2_RS = 272, H2_ARR = 64 * H2_RS;
constexpr int H2_Q2 = 0, H2_QM = H2_ARR, H2_KM = 2 * H2_ARR, H2_KE = 3 * H2_ARR, H2_V = 4 * H2_ARR;
constexpr int H2_SB = 5 * H2_ARR;
constexpr int H2_TOT = H2_SB + 128 * H2_RS, H2_D = H2_TOT + 8 * 128 * 4, H2_SS = H2_D + 512, H2_END = H2_SS + 4 * 64 * 4;
static_assert(H2_END <= RING_BYTES, "HGRN2 LDS map");
template <bool OUT> __device__ __forceinline__ void hgrn2_item(const HgT& T, LAS unsigned char* lds, int bh, int seg, int tid) {
    const int w = __builtin_amdgcn_readfirstlane(tid >> 6), lane = tid & 63, l31 = lane & 31, hh = lane >> 5;
    const int tb = w & 1, vb = w >> 1, kp = lane;
    const int b = bh >> 4, h = bh & 15, c0 = h * HD;
    const size_t m0 = (size_t)b * SEQ + (size_t)seg * HG_SEGLEN;
    const int it0 = bh * HG_NSEG + seg;
    LAS float* tot = (LAS float*)(lds + H2_TOT); LAS float* dvec = (LAS float*)(lds + H2_D); LAS float* ssq = (LAS float*)(lds + H2_SS);
    const int g = lane >> 4, tq = (lane & 15) >> 2, tp = lane & 3;
    const int tr_off = tq * H2_RS + (16 * (g & 1) + 4 * tp) * 2;
    f32x16 S[2];
#pragma unroll
    for (int i = 0; i < 2; ++i)
#pragma unroll
        for (int r = 0; r < 16; ++r) S[i][r] = 0.f;
    if (OUT) {
        for (int j = 0; j < seg; ++j) { const int itj = bh * HG_NSEG + j;
#pragma unroll
            for (int i = 0; i < 2; ++i) { const int kb = 2 * (w & 1) + i;
#pragma unroll
                for (int rq = 0; rq < 4; ++rq) { const int k0 = 32 * kb + 8 * rq + 4 * hh; const f32x4 dj = *(const GAS f32x4*)(T.DSEG + itj * 128 + k0);
#pragma unroll
                    for (int e = 0; e < 4; ++e) S[i][4 * rq + e] = dj[e] * S[i][4 * rq + e] + T.SEND[((size_t)itj * 128 + k0 + e) * 128 + 32 * vb + l31]; } } }
#pragma unroll
        for (int i = 0; i < 2; ++i) { const int kb = 2 * (w & 1) + i;
#pragma unroll
            for (int rq = 0; rq < 4; ++rq) { v2u o; o.x = cvtpk_s(S[i][4 * rq], S[i][4 * rq + 1]); o.y = cvtpk_s(S[i][4 * rq + 2], S[i][4 * rq + 3]);
                *(LAS v2u*)(lds + H2_SB + (32 * vb + l31) * H2_RS + (32 * kb + 8 * rq + 4 * hh) * 2) = o; } }
    }
    float dtot0 = 1.f, dtot1 = 1.f;
    f32x2_t fr[8]; unsigned qr[8]; v4u vr[2];
    const int lr = tid >> 4, lc = tid & 15;
#define H2_LOAD(c) do { const size_t mrow_ = m0 + (size_t)(c) * 64; \
        _Pragma("unroll") for (int i = 0; i < 8; ++i) { const size_t o_ = (mrow_ + 8 * w + i) * DH + c0 + 2 * kp; fr[i] = *(const GAS f32x2_t*)(T.F + o_); if (OUT) qr[i] = *(const GAS unsigned*)(T.QA + o_); } \
        _Pragma("unroll") for (int i = 0; i < 2; ++i) vr[i] = *(const GAS v4u*)(T.IA + (mrow_ + lr + 32 * i) * DH + c0 + 8 * lc); } while (0)
    H2_LOAD(0);
    for (int c = 0; c < HG_SEGLEN / 64; ++c) {
        const size_t mrow = m0 + (size_t)c * 64;
        float pre0[8], pre1[8], suf0[8], suf1[8];
        { float a0 = 1.f, a1 = 1.f;
#pragma unroll
          for (int i = 0; i < 8; ++i) { a0 *= fr[i].x; a1 *= fr[i].y; pre0[i] = a0; pre1[i] = a1; }
          float s0 = 1.f, s1 = 1.f;
#pragma unroll
          for (int i = 7; i >= 0; --i) { suf0[i] = s0; suf1[i] = s1; s0 *= fr[i].x; s1 *= fr[i].y; } }
        *(LAS f32x2_t*)(tot + w * 128 + 2 * kp) = (f32x2_t){pre0[7], pre1[7]};
        __syncthreads();
        float ps0 = 1.f, ps1 = 1.f, pe0 = 1.f, pe1 = 1.f, pm0 = 1.f, pm1 = 1.f, pa0 = 1.f, pa1 = 1.f;
#pragma unroll
        for (int j = 0; j < 8; ++j) { const f32x2_t tj = *(const LAS f32x2_t*)(tot + j * 128 + 2 * kp);
            pa0 *= tj.x; pa1 *= tj.y;
            const bool cs = j < w, ce = j > w, cm = (w <= 3) ? (j > w && j <= 3) : (j >= 4 && j < w);
            ps0 *= cs ? tj.x : 1.0f; ps1 *= cs ? tj.y : 1.0f; pe0 *= ce ? tj.x : 1.0f; pe1 *= ce ? tj.y : 1.0f; pm0 *= cm ? tj.x : 1.0f; pm1 *= cm ? tj.y : 1.0f; }
        if (w == 0) { *(LAS f32x2_t*)(dvec + 2 * kp) = (f32x2_t){pa0, pa1}; dtot0 *= pa0; dtot1 *= pa1; }
#pragma unroll
        for (int i = 0; i < 8; ++i) {
            const int t = 8 * w + i;
            const float k0 = 1.0f - fr[i].x, k1 = 1.0f - fr[i].y;
            const float ee0 = suf0[i] * pe0, ee1 = suf1[i] * pe1;
            *(LAS unsigned*)(lds + H2_KE + t * H2_RS + 4 * kp) = cvtpk_s(k0 * ee0, k1 * ee1);
            if (OUT) {
                const float q0 = bflo(qr[i]), q1 = bfhi(qr[i]);
                const float es0 = ps0 * pre0[i], es1 = ps1 * pre1[i];
                float em0, em1, ei0, ei1;
                if (w <= 3) { ei0 = fmaxf(suf0[i] * pm0, 1e-30f); ei1 = fmaxf(suf1[i] * pm1, 1e-30f); em0 = __builtin_amdgcn_rcpf(ei0); em1 = __builtin_amdgcn_rcpf(ei1); }
                else        { em0 = fmaxf(pm0 * pre0[i], 1e-30f); em1 = fmaxf(pm1 * pre1[i], 1e-30f); ei0 = __builtin_amdgcn_rcpf(em0); ei1 = __builtin_amdgcn_rcpf(em1); }
                *(LAS unsigned*)(lds + H2_Q2 + t * H2_RS + 4 * kp) = cvtpk_s(q0 * es0, q1 * es1);
                *(LAS unsigned*)(lds + H2_QM + t * H2_RS + 4 * kp) = cvtpk_s(q0 * em0, q1 * em1);
                *(LAS unsigned*)(lds + H2_KM + t * H2_RS + 4 * kp) = cvtpk_s(k0 * ei0, k1 * ei1);
            }
        }
#pragma unroll
        for (int i = 0; i < 2; ++i) *(LAS v4u*)(lds + H2_V + (lr + 32 * i) * H2_RS + lc * 16) = vr[i];
        __syncthreads();
        if (c + 1 < HG_SEGLEN / 64) H2_LOAD(c + 1);
        v2u gq[4];
        if (OUT) {
#pragma unroll
            for (int rq = 0; rq < 4; ++rq) gq[rq] = *(const GAS v2u*)(T.GA + (mrow + 32 * tb + l31) * DH + c0 + 32 * vb + 8 * rq + 4 * hh);
        }
#pragma unroll
        for (int i = 0; i < 2; ++i) { const int kb = 2 * (w & 1) + i;
#pragma unroll
            for (int rq = 0; rq < 4; ++rq) { const f32x4 d4 = *(const LAS f32x4*)(dvec + 32 * kb + 8 * rq + 4 * hh);
#pragma unroll
                for (int e = 0; e < 4; ++e) S[i][4 * rq + e] *= d4[e]; } }
#pragma unroll
        for (int st = 0; st < 4; ++st) {
            const LAS unsigned char* pv = lds + H2_V + (16 * st + 8 * hh) * H2_RS + (32 * vb) * 2 + tr_off;
            const s16x4 v_lo = vtr(pv), v_hi = vtr(pv + 4 * H2_RS);
            const bf16x8 vfr = (bf16x8){v_lo[0], v_lo[1], v_lo[2], v_lo[3], v_hi[0], v_hi[1], v_hi[2], v_hi[3]};
#pragma unroll
            for (int i = 0; i < 2; ++i) { const int kb = 2 * (w & 1) + i;
                const LAS unsigned char* pk = lds + H2_KE + (16 * st + 8 * hh) * H2_RS + (32 * kb) * 2 + tr_off;
                const s16x4 k_lo = vtr(pk), k_hi = vtr(pk + 4 * H2_RS);
                const bf16x8 kfr = (bf16x8){k_lo[0], k_lo[1], k_lo[2], k_lo[3], k_hi[0], k_hi[1], k_hi[2], k_hi[3]};
                S[i] = __builtin_amdgcn_mfma_f32_32x32x16_bf16(kfr, vfr, S[i], 0, 0, 0); }
        }
        f32x16 oT;
        if (OUT) {
            f32x16 PT[2];
#pragma unroll
            for (int sb = 0; sb < 2; ++sb)
#pragma unroll
                for (int r = 0; r < 16; ++r) PT[sb][r] = 0.f;
#pragma unroll
            for (int ks = 0; ks < 8; ++ks) {
                const bf16x8 qb = *(const LAS bf16x8*)(lds + H2_QM + (32 * tb + l31) * H2_RS + 32 * ks + 16 * hh);
                const bf16x8 ka = *(const LAS bf16x8*)(lds + H2_KM + l31 * H2_RS + 32 * ks + 16 * hh);
                PT[0] = __builtin_amdgcn_mfma_f32_32x32x16_bf16(ka, qb, PT[0], 0, 0, 0);
                if (tb == 1) { const bf16x8 kb1 = *(const LAS bf16x8*)(lds + H2_KM + (32 + l31) * H2_RS + 32 * ks + 16 * hh);
                    PT[1] = __builtin_amdgcn_mfma_f32_32x32x16_bf16(kb1, qb, PT[1], 0, 0, 0); }
            }
#pragma unroll
            for (int r = 0; r < 16; ++r) { const int sl = 8 * (r >> 2) + 4 * hh + (r & 3); const bool drop = sl > l31;
                PT[0][r] = (drop && tb == 0) ? 0.f : PT[0][r]; PT[1][r] = (drop && tb == 1) ? 0.f : PT[1][r]; }
#pragma unroll
            for (int r = 0; r < 16; ++r) oT[r] = 0.f;
#pragma unroll
            for (int ks = 0; ks < 8; ++ks) {
                const bf16x8 sa = *(const LAS bf16x8*)(lds + H2_SB + (32 * vb + l31) * H2_RS + 32 * ks + 16 * hh);
                const bf16x8 qb = *(const LAS bf16x8*)(lds + H2_Q2 + (32 * tb + l31) * H2_RS + 32 * ks + 16 * hh);
                oT = __builtin_amdgcn_mfma_f32_32x32x16_bf16(sa, qb, oT, 0, 0, 0);
            }
#pragma unroll
            for (int sb = 0; sb < 2; ++sb) {
                if (sb <= tb) {
#pragma unroll
                    for (int s2 = 0; s2 < 2; ++s2) {
                        const bf16x8 pb = pack8(PT[sb][8 * s2 + 0], PT[sb][8 * s2 + 1], PT[sb][8 * s2 + 2], PT[sb][8 * s2 + 3], PT[sb][8 * s2 + 4], PT[sb][8 * s2 + 5], PT[sb][8 * s2 + 6], PT[sb][8 * s2 + 7]);
                        const LAS unsigned char* pv = lds + H2_V + (32 * sb + 16 * s2 + 4 * hh) * H2_RS + (32 * vb) * 2 + tr_off;
                        const s16x4 lo = vtr(pv), hi = vtr(pv + 8 * H2_RS);
                        const bf16x8 va = (bf16x8){lo[0], lo[1], lo[2], lo[3], hi[0], hi[1], hi[2], hi[3]};
                        oT = __builtin_amdgcn_mfma_f32_32x32x16_bf16(va, pb, oT, 0, 0, 0);
                    }
                }
            }
            float ss = 0.f;
#pragma unroll
            for (int r = 0; r < 16; ++r) ss += oT[r] * oT[r];
            ss += __shfl_xor(ss, 32);
            if (hh == 0) ssq[vb * 64 + 32 * tb + l31] = ss;
        }
        __syncthreads();
        if (OUT) {
            const int t = 32 * tb + l31;
            const float tot2 = (ssq[t] + ssq[64 + t]) + (ssq[128 + t] + ssq[192 + t]);
            const float rn = 1.0f / sqrtf(tot2 * (1.f / HD) + NORM_EPS);
#pragma unroll
            for (int rq = 0; rq < 4; ++rq) { v2u o; const f32x4 n4 = *(const GAS f32x4*)(T.normg + c0 + 32 * vb + 8 * rq + 4 * hh);
                o.x = pk2(oT[4 * rq] * rn * n4[0] * bflo(gq[rq].x), oT[4 * rq + 1] * rn * n4[1] * bfhi(gq[rq].x));
                o.y = pk2(oT[4 * rq + 2] * rn * n4[2] * bflo(gq[rq].y), oT[4 * rq + 3] * rn * n4[3] * bfhi(gq[rq].y));
                *(GAS v2u*)(T.YA + (mrow + t) * D + c0 + 32 * vb + 8 * rq + 4 * hh) = o; }
#pragma unroll
            for (int i = 0; i < 2; ++i) { const int kb = 2 * (w & 1) + i;
#pragma unroll
                for (int rq = 0; rq < 4; ++rq) { v2u o; o.x = cvtpk_s(S[i][4 * rq], S[i][4 * rq + 1]); o.y = cvtpk_s(S[i][4 * rq + 2], S[i][4 * rq + 3]);
                    *(LAS v2u*)(lds + H2_SB + (32 * vb + l31) * H2_RS + (32 * kb + 8 * rq + 4 * hh) * 2) = o; } }
        }
    }
#undef H2_LOAD
    if (!OUT) {
#pragma unroll
        for (int i = 0; i < 2; ++i) { const int kb = 2 * (w & 1) + i;
#pragma unroll
            for (int r = 0; r < 16; ++r) T.SEND[((size_t)it0 * 128 + 32 * kb + 8 * (r >> 2) + 4 * hh + (r & 3)) * 128 + 32 * vb + l31] = S[i][r]; }
        if (w == 0) *(GAS f32x2_t*)(T.DSEG + it0 * 128 + 2 * kp) = (f32x2_t){dtot0, dtot1};
    }
    __syncthreads();
}

struct Args { const float* in[21]; float* out; unsigned char* ws; int ph_lo, ph_hi, li, pad; };
__global__ void __launch_bounds__(NWAVES * 64, 2) mk_fwd(Args args) {
    extern __shared__ __attribute__((aligned(16))) unsigned char lds_raw[];
    LAS unsigned char* lds = (LAS unsigned char*)lds_raw;
    volatile LAS unsigned* MISC = (volatile LAS unsigned*)(lds + MISC_OFF);
    const int wave = __builtin_amdgcn_readfirstlane(threadIdx.x >> 6);
#define TID_HERE() const int lane = lane_now(), tid = wave * 64 + lane; (void)tid; (void)lane
    const int G = gridDim.x;
    unsigned char* ws = args.ws;
    gu32* ctl = (gu32*)(ws + WS_CTL);
    { TID_HERE(); for (int u = tid; u < (LDS_BYTES - LDSCTL_OFF) / 4; u += NWAVES * 64) ((LAS unsigned*)(lds + LDSCTL_OFF))[u] = 0u; }
    __syncthreads();
    XcdBarrier bar; bar.bar = (unsigned*)(ctl + CW_BAR); bar.x = 0; bar.st = nullptr; bar.w0 = (wave == 0);
    if (MK_N_LAUNCHES == 1) bar = xcd_barrier_post((unsigned*)(ctl + CW_BAR), MISC + 8, wave == 0);
#define GRID_BAR() do { if (MK_N_LAUNCHES == 1) xcd_barrier(bar); } while (0)
    const int lo = args.ph_lo, hi = args.ph_hi;
#define IN(k) (lo <= (k) && (k) < hi)
#define BOTH(k) (IN(k) && IN((k) + 1))
    const float* x = args.in[0]; float* out = args.out;
    bf16* W13_1 = (bf16*)(ws + WS_W13_1); bf16* W2_1 = (bf16*)(ws + WS_W2_1); bf16* W13_2 = (bf16*)(ws + WS_W13_2); bf16* W2_2 = (bf16*)(ws + WS_W2_2);
    bf16* WIN = (bf16*)(ws + WS_WIN); bf16* WUAB = (bf16*)(ws + WS_WUA); bf16* WO = (bf16*)(ws + WS_WO);
    bf16* XN = (bf16*)(ws + WS_XN); bf16* Y = (bf16*)(ws + WS_Y); bf16* HID = (bf16*)(ws + WS_HID);
    float* LB = (float*)(ws + WS_LB);
    bf16* X1B = (bf16*)(ws + WS_W13_1);
    unsigned char* XQG = ws + WS_W2_1;
    unsigned char* XQF = (unsigned char*)(ws + WS_XN);
    unsigned char* WGQ = ws + WS_WIN + (size_t)NPROJ * D * 2;
    unsigned char* W13Q_1 = ws + WS_W13_1; unsigned char* W13Q_2 = ws + WS_W13_2;
    float* CM1 = (float*)(ws + WS_CM1); float* CM2 = (float*)(ws + WS_CM2); float* CMG = (float*)(ws + WS_CMG);
    float* SA1 = (float*)(ws + WS_SA1); float* SA2 = (float*)(ws + WS_SA2); float* SAG = (float*)(ws + WS_SAG);
    unsigned* CMD1 = (unsigned*)(ws + WS_CMD1); unsigned* CMD2 = (unsigned*)(ws + WS_CMD2); float* SAH = (float*)(ws + WS_SAH);
    unsigned char* HQ = ws + WS_HQ;
    bf16* XB = (bf16*)(ws + WS_Y + 128 * MiB);
    unsigned char* W2Q_1 = ws + WS_W2_1; unsigned char* W2Q_2 = ws + WS_W2_2;
    bf16* X2B = (bf16*)(ws + WS_WIN);
    const int gw = blockIdx.x * NWAVES + wave, NGW = G * NWAVES;

    if (IN(0)) {
        TID_HERE();
        LAS float* scr = (LAS float*)(lds + RING_OFF + wave * 16384);
        constexpr int I_2 = (DFF / 64) * (D / 32), I_IN = (D / 64) * (NPROJ / 32), I_U = (DH / 64) * (D / 32), I_O = (D / 64) * (D / 32);
        constexpr int Q_G = DFF / 32, Q_8 = NGATE / 32;
        if constexpr (DQ1 || DQ2) {
            if constexpr (DQ2) { constexpr int nb0 = TAILW2 ? TAILNB : 0, nbn = D / 32 - nb0; for (int it = gw; it < (DFF / 64) * nbn; it += NGW) w2_had_item<false>(args.in[20], nullptr, CMD2, it, scr, lane, nb0, nbn); }
            if constexpr (DQ1) for (int it = gw; it < I_2; it += NGW) w2_had_item<false>(args.in[5], nullptr, CMD1, it, scr, lane);
            GRID_BAR();
            if constexpr (DQ1) for (int it = gw; it < I_2; it += NGW) w2_had_item<true>(args.in[5], W2Q_1, CMD1, it, scr, lane);
        }
        __syncthreads();
        for (int it = blockIdx.x; it < 4 * Q_G + Q_8; it += G) {
            if (it < 4 * Q_G) { const int mat = it / Q_G, n0 = 32 * (it % Q_G);
                const float* W = mat == 0 ? args.in[3] : mat == 1 ? args.in[4] : mat == 2 ? args.in[18] : args.in[19];
                wg_q8_item_h(W, DFF, n0, mat < 2 ? W13Q_1 : W13Q_2, 256 * (n0 >> 7) + (n0 & 127) + 128 * (mat & 1), mat < 2 ? CM1 : CM2, lds, wave, lane); }
            else { const int d0 = 32 * (it - 4 * Q_G); wg_q8_item_h(args.in[8], NIN, win_src_q8(d0), WGQ, d0, CMG, lds, wave, lane); }
        }
        {
            constexpr int NA = 2 * I_2 + I_IN + 2 * I_U + I_O;
            for (int it = gw; it < NA; it += NGW) {
                int r = it;
                if (r < I_2) { if constexpr (!DQ1) tr_plain(args.in[5], DFF, D, W2_1, r, scr, lane); continue; } r -= I_2;
                if (r < I_2) { if constexpr (DQ2) { constexpr int nb0 = TAILW2 ? TAILNB : 0, nbn = D / 32 - nb0; if (r < (DFF / 64) * nbn) w2_had_item<true>(args.in[20], W2Q_2, CMD2, r, scr, lane, nb0, nbn); } else tr_plain(args.in[20], DFF, D, W2_2, r, scr, lane); continue; } r -= I_2;
                if (r < I_IN) { const int kb = r / (NPROJ / 32), nb = r % (NPROJ / 32); tr_item(args.in[8], D, NIN, WIN, 64 * kb, win_src_bf(32 * nb), 32 * nb, scr, lane); continue; } r -= I_IN;
                if (r < I_U) { const int kb = r / (D / 32), nb = r % (D / 32); tr_item(args.in[13], D, D, WUAB, 64 * kb, 32 * nb, 32 * nb, scr, lane, 64 * kb); continue; } r -= I_U;
                if (r < I_U) { const int kb = r / (D / 32), nb = r % (D / 32); tr_item(args.in[14], D, D, WUAB, 64 * kb, 32 * nb, 32 * nb, scr, lane, DH + 64 * kb); continue; } r -= I_U;
                tr_plain(args.in[15], D, D, WO, r, scr, lane);
            }
            if (blockIdx.x == 0) { for (int i = tid; i < DH; i += NWAVES * 64) { const float l0 = args.in[10][i], l1 = args.in[10][DH + i]; LB[i] = 1.0f / (1.0f + __expf(l1 - l0)); } }
            for (int m = gw; m < M; m += NGW) rms_row_to_q8(x + (size_t)m * D, args.in[1], XQF + (size_t)m * D, SA1 + m, lane, XB + (size_t)m * D);
        }
        if (BOTH(0)) GRID_BAR();
    }
    if (IN(1)) {
        pg8::Gemm g{(const bf16*)XQF, (const bf16*)W13Q_1, M, NUP, D / 2}; pg8::StaticOrder S; S.init(M, NUP, G, (int)blockIdx.x); S.wv = wave;
        pg8::EpiSwigluQ8T<DQ1> E{HID, DFF, SA1, CM1};
        pg8::gemm_phase<pg8::EpiSwigluQ8T<DQ1>, pg8::StaticOrder, true, true, true>(lds + RING_OFF, g, S, E);
        if constexpr (TAILW2) {
            const int nun = (M / 256) * (NUP / 256), tailc = nun % G, base = tailc ? tailc : 0, NI = G - base;
            if ((int)blockIdx.x >= base) { TID_HERE(); LAS float* scr = (LAS float*)(lds + RING_OFF + wave * 16384);
                w2_had_stream<false>(args.in[20], nullptr, CMD2, ((int)blockIdx.x - base) * NWAVES + wave, NI * NWAVES, (DFF / 64) * TAILNB, scr, lane, TAILNB); } }
        if (BOTH(1)) GRID_BAR();
        if constexpr (DQ1) { TID_HERE(); for (int m = gw; m < M; m += NGW) hid_row_to_q8(HID + (size_t)m * DFF, HQ + (size_t)m * DFF, SAH + m, lane); GRID_BAR(); }
    }
    if (IN(2)) {
        if constexpr (DQ1) { pg8::Gemm g{(const bf16*)HQ, (const bf16*)W2Q_1, M, D, DFF / 2}; pg8::StaticOrder S; S.init(M, D, G, (int)blockIdx.x); S.wv = wave;
            pg8::EpiBf16Q8 E{Y, D, SAH, (const float*)CMD1, 1.0f / 32.0f};
            pg8::gemm_phase<pg8::EpiBf16Q8, pg8::StaticOrder, true, true, true>(lds + RING_OFF, g, S, E); }
        else { pg8::Gemm g{HID, W2_1, M, D, DFF}; pg8::StaticOrder S; S.init(M, D, G, (int)blockIdx.x); S.wv = wave;
            pg8::EpiBf16Plain E{Y, D};
            pg8::gemm_phase<pg8::EpiBf16Plain, pg8::StaticOrder, true, true>(lds + RING_OFF, g, S, E); }
        if (BOTH(2)) GRID_BAR();
    }
    if (IN(3)) {
        TID_HERE();
        for (int m = gw; m < M; m += NGW) post_row<true, true, true, true, true>(Y + (size_t)m * D, XB + (size_t)m * D, X1B + (size_t)m * D, args.in[2], 0.5f, args.in[6], XN + (size_t)m * D, lane, XQG + (size_t)m * D, SAG + m);
        if (BOTH(3)) GRID_BAR();
    }
    if (IN(4)) {
        { pg8::Gemm g{(const bf16*)XQG, (const bf16*)WGQ, M, NGATE, D / 2}; pg8::StaticOrder S; S.init(M, NGATE, G, (int)blockIdx.x); S.wv = wave;
          pg8::EpiGatesQ8 E{(bf16*)(ws + WS_GTA), (bf16*)(ws + WS_GTB), (float*)(ws + WS_F), LB, args.in[9], SAG, CMG,
                            (bf16*)(ws + WS_QA), (bf16*)(ws + WS_IA), (bf16*)(ws + WS_GA), (bf16*)(ws + WS_QB), (bf16*)(ws + WS_KB), (bf16*)(ws + WS_VB), 0.08838834764831845f * 1.4426950408889634f};
          pg8::gemm_phase<pg8::EpiGatesQ8, pg8::StaticOrder, true, true, true>(lds + RING_OFF, g, S, E); }
        { pg8::Gemm g{XN, WIN, M, NPROJ, D}; pg8::StaticOrder S; S.init(M, NPROJ, G, (int)blockIdx.x); S.wv = wave;
          pg8::EpiProj E{(bf16*)(ws + WS_QA), (bf16*)(ws + WS_IA), (bf16*)(ws + WS_GA), (bf16*)(ws + WS_QB), (bf16*)(ws + WS_KB), (bf16*)(ws + WS_VB),
                         0.08838834764831845f * 1.4426950408889634f};
          pg8::gemm_phase<pg8::EpiProj, pg8::StaticOrder, true, true>(lds + RING_OFF, g, S, E); }
        if (BOTH(4)) GRID_BAR();
    }
    const HgT HT{(const float*)(ws + WS_F), (const bf16*)(ws + WS_QA), (const bf16*)(ws + WS_IA), (const bf16*)(ws + WS_GA), args.in[11], (float*)(ws + WS_SEND), (float*)(ws + WS_DSEG), (bf16*)(ws + WS_YAB)};
    if (IN(5)) {
        TID_HERE();
        for (int it = blockIdx.x; it < 32 * HG_NSEG; it += G) { const int bh = it >> 3, seg = it & 7; if (seg < HG_NSEG - 1) hgrn2_item<false>(HT, lds, bh, seg, tid); }
        const AtT AT{(const bf16*)(ws + WS_QB), (const bf16*)(ws + WS_KB), (const bf16*)(ws + WS_VB), args.in[12], (bf16*)(ws + WS_YAB) + DH};
        for (int it = blockIdx.x; it < 1024; it += G) attn_item(AT, lds, it & 31, it >> 5, tid);
        if (BOTH(5)) GRID_BAR();
    }
    if (IN(6)) {
        TID_HERE();
        for (int it = blockIdx.x; it < 32 * HG_NSEG; it += G) hgrn2_item<true>(HT, lds, it >> 3, it & 7, tid);
        if (BOTH(6)) GRID_BAR();
    }
    if (IN(7)) {
        pg8::Gemm g{(const bf16*)(ws + WS_YAB), WUAB, M, D, D}; pg8::StaticOrder S; S.init(M, D, G, (int)blockIdx.x); S.wv = wave;
        pg8::EpiUpGate E{(bf16*)(ws + WS_MX), (const unsigned char*)(ws + WS_GTA), (const unsigned char*)(ws + WS_GTB)};
        pg8::gemm_phase<pg8::EpiUpGate, pg8::StaticOrder, true, true>(lds + RING_OFF, g, S, E);
        if (BOTH(7)) GRID_BAR();
    }
    if (IN(9)) {
        pg8::Gemm g{(const bf16*)(ws + WS_MX), WO, M, D, D}; pg8::StaticOrder S; S.init(M, D, G, (int)blockIdx.x); S.wv = wave;
        pg8::EpiBf16Plain E{Y, D};
        pg8::gemm_phase<pg8::EpiBf16Plain, pg8::StaticOrder, true, true>(lds + RING_OFF, g, S, E);
        if (BOTH(9)) GRID_BAR();
    }
    if (IN(10)) {
        TID_HERE();
        for (int m = gw; m < M; m += NGW) post_row<true, true, true, false, true>(Y + (size_t)m * D, X1B + (size_t)m * D, X2B + (size_t)m * D, args.in[7], 1.0f, args.in[16], nullptr, lane, XQF + (size_t)m * D, SA2 + m);
        if (BOTH(10)) GRID_BAR();
    }
    if (IN(11)) {
        pg8::Gemm g{(const bf16*)XQF, (const bf16*)W13Q_2, M, NUP, D / 2}; pg8::StaticOrder S; S.init(M, NUP, G, (int)blockIdx.x); S.wv = wave;
        pg8::EpiSwigluQ8T<DQ2> E{HID, DFF, SA2, CM2};
        pg8::gemm_phase<pg8::EpiSwigluQ8T<DQ2>, pg8::StaticOrder, true, true, true>(lds + RING_OFF, g, S, E);
        if constexpr (TAILW2) {
            const int nun = (M / 256) * (NUP / 256), tailc = nun % G, base = tailc ? tailc : 0, NI = G - base;
            if ((int)blockIdx.x >= base) { TID_HERE(); LAS float* scr = (LAS float*)(lds + RING_OFF + wave * 16384);
                w2_had_stream<true>(args.in[20], W2Q_2, CMD2, ((int)blockIdx.x - base) * NWAVES + wave, NI * NWAVES, (DFF / 64) * TAILNB, scr, lane, TAILNB); } }
        if (BOTH(11)) GRID_BAR();
        if constexpr (DQ2) { TID_HERE(); for (int m = gw; m < M; m += NGW) hid_row_to_q8(HID + (size_t)m * DFF, HQ + (size_t)m * DFF, SAH + m, lane); GRID_BAR(); }
    }
    if (IN(12)) {
        if constexpr (DQ2) { pg8::Gemm g{(const bf16*)HQ, (const bf16*)W2Q_2, M, D, DFF / 2}; pg8::StaticOrder S; S.init(M, D, G, (int)blockIdx.x); S.wv = wave;
            pg8::EpiBf16Q8 E{Y, D, SAH, (const float*)CMD2, 1.0f / 32.0f};
            pg8::gemm_phase<pg8::EpiBf16Q8, pg8::StaticOrder, true, true, true>(lds + RING_OFF, g, S, E); }
        else { pg8::Gemm g{HID, W2_2, M, D, DFF}; pg8::StaticOrder S; S.init(M, D, G, (int)blockIdx.x); S.wv = wave;
            pg8::EpiBf16Plain E{Y, D};
            pg8::gemm_phase<pg8::EpiBf16Plain, pg8::StaticOrder, true, true>(lds + RING_OFF, g, S, E); }
        if (BOTH(12)) GRID_BAR();
    }
    if (IN(13)) {
        TID_HERE();
        for (int m = gw; m < M; m += NGW) post_row<false, true, false>(Y + (size_t)m * D, X2B + (size_t)m * D, out + (size_t)m * D, args.in[17], 0.5f, nullptr, nullptr, lane);
    }
#undef IN
#undef BOTH
#undef GRID_BAR
}

extern "C" void kernel_launch(void* const* d_in, const int* in_sizes, int n_in, void* d_out, int out_size, void* d_ws, size_t ws_size, hipStream_t stream) {
    static int grid = 0;
    if (grid == 0) {
        if (n_in != 21 || in_sizes[0] != M * D || out_size != M * D || ws_size < WS_END) { fprintf(stderr, "kernel_launch: unexpected shapes: n_in %d, in0 %d, out %d, ws %zu (need %zu); nothing launched\n", n_in, n_in > 0 ? in_sizes[0] : -1, out_size, ws_size, (size_t)WS_END); grid = -1; return; }
        int dev = 0, cus = 0, per_cu = 0;
        if (hipGetDevice(&dev) != hipSuccess || hipDeviceGetAttribute(&cus, hipDeviceAttributeMultiprocessorCount, dev) != hipSuccess) { fprintf(stderr, "kernel_launch: device query failed\n"); grid = -1; return; }
        if (hipFuncSetAttribute((const void*)mk_fwd, hipFuncAttributeMaxDynamicSharedMemorySize, LDS_BYTES) != hipSuccess) { fprintf(stderr, "kernel_launch: hipFuncSetAttribute failed\n"); grid = -1; return; }
        if (hipOccupancyMaxActiveBlocksPerMultiprocessor(&per_cu, (const void*)mk_fwd, NWAVES * 64, LDS_BYTES) != hipSuccess || per_cu < 1)
            fprintf(stderr, "kernel_launch: note: occupancy query reports %d workgroups per CU\n", per_cu);
        (void)hipGetLastError();
        grid = cus;
    }
    if (grid < 0) return;
    if (hipMemsetAsync((char*)d_ws + WS_CTL, 0, CTL_ZERO_BYTES, stream) != hipSuccess) { fprintf(stderr, "kernel_launch: memset failed\n"); return; }
    Args a{};
    for (int i = 0; i < 21; ++i) a.in[i] = (const float*)d_in[i];
    a.out = (float*)d_out; a.ws = (unsigned char*)d_ws;
    for (int li = 0; li < MK_N_LAUNCHES; ++li) {
        if (MK_N_LAUNCHES == 1) { a.ph_lo = 0; a.ph_hi = NPHASE; } else { a.ph_lo = li; a.ph_hi = li + 1; }
        a.li = li;
        hipLaunchKernelGGL(mk_fwd, dim3(grid), dim3(NWAVES * 64), LDS_BYTES, stream, a);
        const hipError_t le = hipPeekAtLastError();
        if (le != hipSuccess) { fprintf(stderr, "kernel_launch: launch %d failed: %s\n", li, hipGetErrorName(le)); break; }
    }
}
```

```cpp
#include <hip/hip_runtime.h>
#include <cstdio>
#include <cstdint>
__device__ __forceinline__ int lane_now() { unsigned m = ~0u; asm volatile("" : "+s"(m)); return (int)__builtin_amdgcn_mbcnt_hi(m, __builtin_amdgcn_mbcnt_lo(m, 0u)); }
__device__ __forceinline__ void wht8(float (&v)[8]) {
#pragma unroll
    for (int h = 1; h < 8; h <<= 1)
#pragma unroll
        for (int i = 0; i < 8; i += 2 * h)
#pragma unroll
            for (int j = i; j < i + h; ++j) { const float a = v[j], b = v[j + h]; v[j] = a + b; v[j + h] = a - b; }
}
__device__ __forceinline__ void wht_x(float (&v)[8], int mask, int lane) {
    const float sg = (lane & mask) ? -1.0f : 1.0f;
#pragma unroll
    for (int i = 0; i < 8; ++i) { const float p = __shfl_xor(v[i], mask); v[i] = __builtin_fmaf(v[i], sg, p); }
}
template <int CTRL>
__device__ __forceinline__ float dpp_f(float x) { return __builtin_bit_cast(float, __builtin_amdgcn_update_dpp(0, __builtin_bit_cast(int, x), CTRL, 0xF, 0xF, true)); }
template <int CTRL>
__device__ __forceinline__ void wht_q(float (&v)[8], int mask, int lane) {
    const float sg = (lane & mask) ? -1.0f : 1.0f;
#pragma unroll
    for (int i = 0; i < 8; ++i) { const float p = dpp_f<CTRL>(v[i]); v[i] = __builtin_fmaf(v[i], sg, p); }
}
constexpr int NQ8S = 1;
__host__ __device__ constexpr int q8_seg(int s) { return NQ8S == 1 ? 1 : (s == 0 ? 1 : s == 1 ? 2 : 6); }
__host__ __device__ constexpr int bf_seg(int s) { return NQ8S == 1 ? (s == 0 ? 0 : s + 1) : (s == 0 ? 0 : s == 1 ? 3 : s == 2 ? 4 : 5); }
constexpr bool DQ1 = true, DQ2 = true;
constexpr bool W2ROT = true;
constexpr int TAILNB = 80;
constexpr bool TAILW2 = DQ2 && !W2ROT;
namespace pg8 {
#define PG8_LAS __attribute__((address_space(3)))
typedef unsigned short bf16_t;
typedef short bf16x8 __attribute__((ext_vector_type(8)));
typedef float f32x4 __attribute__((ext_vector_type(4)));
typedef unsigned u32x4 __attribute__((ext_vector_type(4)));
typedef unsigned u32x2 __attribute__((ext_vector_type(2)));
constexpr int BM = 256, BK = 64, HALF = 128, HTB = HALF * BK * 2  , STAGE_BYTES = 8 * HTB, NXCD = 8, WGM = 4;

__host__ __device__ __forceinline__ int lds_byte(int r, int c) { const int st = (r >> 4) * 2 + (c >> 5), rr = r & 15, cc = c & 31, ob = rr * 64 + cc * 2; return st * 1024 + (ob ^ (((ob >> 9) & 1) << 5)); }
__host__ __device__ __forceinline__ void stage_rc(int b, int& R, int& C) { const int st = b / 1024, sb = b % 1024, swz = sb ^ (((sb >> 9) & 1) << 5); R = (st >> 1) * 16 + swz / 64; C = (st & 1) * 32 + (swz % 64) / 2; }
__host__ __device__ __forceinline__ int perm32(int rho) { const int n = rho >> 4, i = rho & 15; return 8 * (i >> 2) + 4 * n + (i & 3); }

struct Unit { int pm, pn; };
struct Gemm { const bf16_t* A; const bf16_t* Bt; int M, N, K; };

struct StaticOrder {
    int nM, nN, nwg, G, c, wv;
    __host__ __device__ void init(int M, int N, int G_, int c_) { nM = M / BM; nN = N / BM; nwg = nM * nN; G = G_; c = c_; }
    __host__ __device__ bool next(int i, Unit& u) const {
        const long L = (long)i * G + c; if (L >= nwg) return false;
        int wgid = (int)L; { const int q = nwg / NXCD, r = nwg % NXCD, xcd = wgid % NXCD, off = wgid / NXCD; wgid = (xcd < r ? xcd * (q + 1) : r * (q + 1) + (xcd - r) * q) + off; }
        const int nig = WGM * nN, gid = wgid / nig, fm = gid * WGM, gsz = (nM - fm) < WGM ? (nM - fm) : WGM;
        u.pm = fm + ((wgid % nig) % gsz); u.pn = (wgid % nig) / gsz; return true;
    }
    __device__ __forceinline__ void a_ready(const Unit&) const {}
    __device__ __forceinline__ void done(const Unit&) const {}
};

typedef float f32x2c_t __attribute__((ext_vector_type(2))); typedef __bf16 bf16x2c_t __attribute__((ext_vector_type(2)));
__device__ __forceinline__ unsigned cvt_pk_bf16(float lo, float hi) { f32x2c_t v = {lo, hi}; bf16x2c_t b = __builtin_convertvector(v, bf16x2c_t); return __builtin_bit_cast(unsigned, b); }
typedef unsigned u32x2_t __attribute__((ext_vector_type(2)));
__device__ __forceinline__ unsigned pk4_g8(float a, float b, float c, float d) {
    const float MG = 12582912.0f;
    const unsigned ua = __builtin_bit_cast(unsigned, fmaxf(a * 255.0f, 1.0f) + MG), ub = __builtin_bit_cast(unsigned, fmaxf(b * 255.0f, 1.0f) + MG);
    const unsigned uc = __builtin_bit_cast(unsigned, fmaxf(c * 255.0f, 1.0f) + MG), ud = __builtin_bit_cast(unsigned, fmaxf(d * 255.0f, 1.0f) + MG);
    return __builtin_amdgcn_perm(ub, ua, 0x0c0c0400u) | (__builtin_amdgcn_perm(ud, uc, 0x0c0c0400u) << 16);
}
#define G8F(u, i) ((float)(((u) >> (8 * (i))) & 0xffu))
__device__ __forceinline__ float sigm(float x) { return __builtin_amdgcn_rcpf(1.0f + __expf(-x)); }
__device__ __forceinline__ float siluf(float x) { return x * sigm(x); }
__device__ __forceinline__ float bflo(unsigned u) { return __uint_as_float(u << 16); }
__device__ __forceinline__ float bfhi(unsigned u) { return __uint_as_float(u & 0xffff0000u); }

struct EpiSwiglu {
    static constexpr bool PERM = true, AFTER_DRAIN = false; static constexpr int MID_T = -1;
    bf16_t* O; int ldc;
    __device__ __forceinline__ void operator()(const f32x4 (&acc)[2][2][4][2], const Unit& u, int wr, int wc, int fr, int fq) const {
        const int row0 = u.pm * BM + wr * 64 + fr, col0 = u.pn * HALF + wc * 32 + 8 * fq;
#pragma unroll
        for (int ai = 0; ai < 2; ++ai)
#pragma unroll
            for (int m = 0; m < 4; ++m) { bf16_t* rowp = O + (size_t)(row0 + ai * HALF + m * 16) * ldc + col0;
                const f32x4 a0 = acc[ai][0][m][0], a1 = acc[ai][0][m][1], b0 = acc[ai][1][m][0], b1 = acc[ai][1][m][1];
                f32x4 h0, h1;
#pragma unroll
                for (int j = 0; j < 4; ++j) { h0[j] = siluf(a0[j]) * b0[j]; h1[j] = siluf(a1[j]) * b1[j]; }
                u32x4 w; w.x = cvt_pk_bf16(h0[0], h0[1]); w.y = cvt_pk_bf16(h0[2], h0[3]); w.z = cvt_pk_bf16(h1[0], h1[1]); w.w = cvt_pk_bf16(h1[2], h1[3]);
                *(u32x4*)rowp = w; }
    }
};
struct EpiProj {
    static constexpr bool PERM = true, AFTER_DRAIN = false; static constexpr int MID_T = -1;
    bf16_t *QA, *IA, *GA, *QB, *KB, *VB; float qscale;
    __device__ __forceinline__ void operator()(const f32x4 (&acc)[2][2][4][2], const Unit& u, int wr, int wc, int fr, int fq) const {
        const int row0 = u.pm * BM + wr * 64 + fr, cw = wc * 32 + 8 * fq, pn = u.pn;
        {
            const int seg = bf_seg(pn >> 3); const int colt = (pn & 7) * 256 + cw;
            bf16_t* base = seg == 0 ? QA : seg == 2 ? IA : seg == 3 ? GA : seg == 4 ? QB : seg == 5 ? KB : VB;
            const bool do_silu = (seg == 0 || seg == 3); const float sc = (seg == 4) ? qscale : 1.0f;
#pragma unroll
            for (int ai = 0; ai < 2; ++ai)
#pragma unroll
                for (int m = 0; m < 4; ++m) { bf16_t* rowp = base + (size_t)(row0 + ai * HALF + m * 16) * 2048 + colt;
#pragma unroll
                    for (int bj = 0; bj < 2; ++bj) { f32x4 v0 = acc[ai][bj][m][0] * sc, v1 = acc[ai][bj][m][1] * sc;
                        if (do_silu) {
#pragma unroll
                            for (int j = 0; j < 4; ++j) { v0[j] = siluf(v0[j]); v1[j] = siluf(v1[j]); } }
                        u32x4 w; w.x = cvt_pk_bf16(v0[0], v0[1]); w.y = cvt_pk_bf16(v0[2], v0[3]); w.z = cvt_pk_bf16(v1[0], v1[1]); w.w = cvt_pk_bf16(v1[2], v1[3]);
                        *(u32x4*)(rowp + bj * HALF) = w; } }
        }
    }
};
__device__ __forceinline__ float i2f(float bits) { return (float)__builtin_bit_cast(int, bits); }
struct EpiGatesQ8 {
    static constexpr bool PERM = true, AFTER_DRAIN = false; static constexpr int MID_T = -1;
    bf16_t *GTA, *GTB; float* F; const float* lb; const float* bgate; const float* SA; const float* CM; bf16_t *QA, *IA, *GA, *QB, *KB, *VB; float qscale;
    __device__ __forceinline__ void operator()(const f32x4 (&acc)[2][2][4][2], const Unit& u, int wr, int wc, int fr, int fq) const {
        int row0 = u.pm * BM + wr * 64 + fr; const int cw = wc * 32 + 8 * fq, pn = u.pn;
        int qcol = pn * 256 + cw;
        asm volatile("" : "+v"(row0), "+v"(qcol));
        f32x4 cs[2][2];
#pragma unroll
        for (int bj = 0; bj < 2; ++bj)
#pragma unroll
            for (int n = 0; n < 2; ++n) cs[bj][n] = *(const f32x4*)(CM + qcol + bj * HALF + 4 * n) * (1.0f / 127.0f);
        const int seg = pn < 8 * NQ8S ? q8_seg(pn >> 3) : 7;
        if (seg != 1 && seg != 7) {
            const int colt = qcol & 2047;
            bf16_t* base = seg == 0 ? QA : seg == 2 ? IA : seg == 3 ? GA : seg == 4 ? QB : seg == 5 ? KB : VB;
            const bool do_silu = (seg == 0 || seg == 3); const float sc = (seg == 4) ? qscale : 1.0f;
#pragma unroll
            for (int ai = 0; ai < 2; ++ai)
#pragma unroll
                for (int m = 0; m < 4; ++m) { const int row = row0 + ai * HALF + m * 16; const float sa = SA[row] * sc; bf16_t* rowp = base + (size_t)row * 2048 + colt;
#pragma unroll
                    for (int bj = 0; bj < 2; ++bj) { f32x4 v0, v1;
#pragma unroll
                        for (int j = 0; j < 4; ++j) { v0[j] = i2f(acc[ai][bj][m][0][j]) * sa * cs[bj][0][j]; v1[j] = i2f(acc[ai][bj][m][1][j]) * sa * cs[bj][1][j]; }
                        if (do_silu) {
#pragma unroll
                            for (int j = 0; j < 4; ++j) { v0[j] = siluf(v0[j]); v1[j] = siluf(v1[j]); } }
                        u32x4 w; w.x = cvt_pk_bf16(v0[0], v0[1]); w.y = cvt_pk_bf16(v0[2], v0[3]); w.z = cvt_pk_bf16(v1[0], v1[1]); w.w = cvt_pk_bf16(v1[2], v1[3]);
                        *(u32x4*)(rowp + bj * HALF) = w; } }
        } else if (seg == 1) {
            const int colt = qcol & 2047;
            f32x4 lbv[2][2];
#pragma unroll
            for (int bj = 0; bj < 2; ++bj)
#pragma unroll
                for (int n = 0; n < 2; ++n) lbv[bj][n] = *(const f32x4*)(lb + colt + bj * HALF + 4 * n);
#pragma unroll
            for (int ai = 0; ai < 2; ++ai)
#pragma unroll
                for (int m = 0; m < 4; ++m) { const int row = row0 + ai * HALF + m * 16; const float sa = SA[row]; float* rowp = F + (size_t)row * 2048 + colt;
#pragma unroll
                    for (int bj = 0; bj < 2; ++bj)
#pragma unroll
                        for (int n = 0; n < 2; ++n) { f32x4 o;
#pragma unroll
                            for (int j = 0; j < 4; ++j) o[j] = lbv[bj][n][j] + (1.0f - lbv[bj][n][j]) * sigm(i2f(acc[ai][bj][m][n][j]) * sa * cs[bj][n][j]);
                            *(f32x4*)(rowp + bj * HALF + 4 * n) = o; } }
        } else {
            const int gcol = qcol - 2048 * NQ8S; const bool isB = gcol >= 4096;
            bf16_t* base = isB ? GTB : GTA; const int colt = gcol & 4095;
            f32x4 bv[2][2];
#pragma unroll
            for (int bj = 0; bj < 2; ++bj)
#pragma unroll
                for (int n = 0; n < 2; ++n) bv[bj][n] = *(const f32x4*)(bgate + gcol + bj * HALF + 4 * n);
#pragma unroll
            for (int ai = 0; ai < 2; ++ai)
#pragma unroll
                for (int m = 0; m < 4; ++m) { const int row = row0 + ai * HALF + m * 16; const float sa = SA[row]; unsigned char* rowp = (unsigned char*)base + (size_t)row * 4096 + colt;
#pragma unroll
                    for (int bj = 0; bj < 2; ++bj) { f32x4 v0, v1;
#pragma unroll
                        for (int j = 0; j < 4; ++j) { v0[j] = sigm(i2f(acc[ai][bj][m][0][j]) * sa * cs[bj][0][j] + bv[bj][0][j]); v1[j] = sigm(i2f(acc[ai][bj][m][1][j]) * sa * cs[bj][1][j] + bv[bj][1][j]); }
                        u32x2_t w; w.x = pk4_g8(v0[0], v0[1], v0[2], v0[3]); w.y = pk4_g8(v1[0], v1[1], v1[2], v1[3]);
                        *(u32x2_t*)(rowp + bj * HALF) = w; } }
        }
    }
};
template <bool HAD>
struct EpiSwigluQ8T {
    static constexpr bool PERM = true, AFTER_DRAIN = false; static constexpr int MID_T = -1;
    bf16_t* O; int ldc; const float* SA; const float* CM;
    __device__ __forceinline__ void operator()(const f32x4 (&acc)[2][2][4][2], const Unit& u, int wr, int wc, int fr, int fq) const {
        int row0 = u.pm * BM + wr * 64 + fr, cw = wc * 32 + 8 * fq;
        asm volatile("" : "+v"(row0), "+v"(cw));
        const int col0 = u.pn * HALF + cw, brow = u.pn * BM + cw;
        f32x4 cs[2][2];
#pragma unroll
        for (int bj = 0; bj < 2; ++bj)
#pragma unroll
            for (int n = 0; n < 2; ++n) cs[bj][n] = *(const f32x4*)(CM + brow + bj * HALF + 4 * n) * (1.0f / 127.0f);
        float sav[2][4];
#pragma unroll
        for (int ai = 0; ai < 2; ++ai)
#pragma unroll
            for (int m = 0; m < 4; ++m) sav[ai][m] = SA[row0 + ai * HALF + m * 16];
#pragma unroll
        for (int ai = 0; ai < 2; ++ai)
#pragma unroll
            for (int m = 0; m < 4; ++m) { const int row = row0 + ai * HALF + m * 16; const float sa = sav[ai][m]; bf16_t* rowp = O + (size_t)row * ldc + col0;
                float v[8];
#pragma unroll
                for (int j = 0; j < 4; ++j) { v[j] = siluf(i2f(acc[ai][0][m][0][j]) * sa * cs[0][0][j]) * (i2f(acc[ai][1][m][0][j]) * sa * cs[1][0][j]);
                                              v[4 + j] = siluf(i2f(acc[ai][0][m][1][j]) * sa * cs[0][1][j]) * (i2f(acc[ai][1][m][1][j]) * sa * cs[1][1][j]); }
                if constexpr (HAD) {
                    const int ln = fr + 16 * fq;
                    wht8(v); wht_x(v, 16, ln); wht_x(v, 32, ln);
                }
                u32x4 w; w.x = cvt_pk_bf16(v[0], v[1]); w.y = cvt_pk_bf16(v[2], v[3]); w.z = cvt_pk_bf16(v[4], v[5]); w.w = cvt_pk_bf16(v[6], v[7]);
                *(u32x4*)rowp = w; }
    }
};
struct EpiBf16Q8 {
    static constexpr bool PERM = true, AFTER_DRAIN = false; static constexpr int MID_T = -1;
    bf16_t* O; int ldc; const float* SA; const float* CM; float mul;
    __device__ __forceinline__ void operator()(const f32x4 (&acc)[2][2][4][2], const Unit& u, int wr, int wc, int fr, int fq) const {
        int row0 = u.pm * BM + wr * 64 + fr, col0 = u.pn * BM + wc * 32 + 8 * fq;
        asm volatile("" : "+v"(row0), "+v"(col0));
        f32x4 cs[2][2];
#pragma unroll
        for (int bj = 0; bj < 2; ++bj)
#pragma unroll
            for (int n = 0; n < 2; ++n) cs[bj][n] = *(const f32x4*)(CM + col0 + bj * HALF + 4 * n) * mul;
#pragma unroll
        for (int ai = 0; ai < 2; ++ai)
#pragma unroll
            for (int m = 0; m < 4; ++m) { const int row = row0 + ai * HALF + m * 16; const float sa = SA[row]; bf16_t* rowp = O + (size_t)row * ldc + col0;
#pragma unroll
                for (int bj = 0; bj < 2; ++bj) { f32x4 v0, v1;
#pragma unroll
                    for (int j = 0; j < 4; ++j) { v0[j] = i2f(acc[ai][bj][m][0][j]) * sa * cs[bj][0][j]; v1[j] = i2f(acc[ai][bj][m][1][j]) * sa * cs[bj][1][j]; }
                    u32x4 w; w.x = cvt_pk_bf16(v0[0], v0[1]); w.y = cvt_pk_bf16(v0[2], v0[3]); w.z = cvt_pk_bf16(v1[0], v1[1]); w.w = cvt_pk_bf16(v1[2], v1[3]);
                    *(u32x4*)(rowp + bj * HALF) = w; } }
    }
};
struct EpiUpGate {
    static constexpr bool PERM = true, AFTER_DRAIN = false; static constexpr int MID_T = 32;
    bf16_t* O; const unsigned char* GA_; const unsigned char* GB_;
    __device__ __forceinline__ void mid(f32x4 (&acc)[2][2][4][2], const Unit& u, int wr, int wc, int fr, int fq) const {
        int row0 = u.pm * BM + wr * 64 + fr, col0 = u.pn * BM + wc * 32 + 8 * fq;
        asm volatile("" : "+v"(row0), "+v"(col0));
#pragma unroll
        for (int ai = 0; ai < 2; ++ai) {
            u32x2_t ga[4][2], gb[4][2];
#pragma unroll
            for (int m = 0; m < 4; ++m)
#pragma unroll
                for (int bj = 0; bj < 2; ++bj) { const size_t off = (size_t)(row0 + ai * HALF + m * 16) * 4096 + col0 + bj * HALF;
                    ga[m][bj] = *(const u32x2_t*)(GA_ + off); gb[m][bj] = *(const u32x2_t*)(GB_ + off); }
#pragma unroll
            for (int m = 0; m < 4; ++m)
#pragma unroll
                for (int bj = 0; bj < 2; ++bj) { const u32x2_t a = ga[m][bj], b = gb[m][bj];
                    acc[ai][bj][m][0][0] *= G8F(a.x, 0) * __builtin_amdgcn_rcpf(G8F(b.x, 0)); acc[ai][bj][m][0][1] *= G8F(a.x, 1) * __builtin_amdgcn_rcpf(G8F(b.x, 1));
                    acc[ai][bj][m][0][2] *= G8F(a.x, 2) * __builtin_amdgcn_rcpf(G8F(b.x, 2)); acc[ai][bj][m][0][3] *= G8F(a.x, 3) * __builtin_amdgcn_rcpf(G8F(b.x, 3));
                    acc[ai][bj][m][1][0] *= G8F(a.y, 0) * __builtin_amdgcn_rcpf(G8F(b.y, 0)); acc[ai][bj][m][1][1] *= G8F(a.y, 1) * __builtin_amdgcn_rcpf(G8F(b.y, 1));
                    acc[ai][bj][m][1][2] *= G8F(a.y, 2) * __builtin_amdgcn_rcpf(G8F(b.y, 2)); acc[ai][bj][m][1][3] *= G8F(a.y, 3) * __builtin_amdgcn_rcpf(G8F(b.y, 3)); }
        }
    }
    __device__ __forceinline__ void operator()(const f32x4 (&acc)[2][2][4][2], const Unit& u, int wr, int wc, int fr, int fq) const {
        const int row0 = u.pm * BM + wr * 64 + fr, col0 = u.pn * BM + wc * 32 + 8 * fq;
        constexpr float q = 1.0f / 255.0f;
#pragma unroll
        for (int ai = 0; ai < 2; ++ai) {
            u32x2_t gb[4][2];
#pragma unroll
            for (int m = 0; m < 4; ++m)
#pragma unroll
                for (int bj = 0; bj < 2; ++bj) gb[m][bj] = *(const u32x2_t*)(GB_ + (size_t)(row0 + ai * HALF + m * 16) * 4096 + col0 + bj * HALF);
#pragma unroll
            for (int m = 0; m < 4; ++m)
#pragma unroll
                for (int bj = 0; bj < 2; ++bj) { const u32x2_t b = gb[m][bj]; const f32x4 v0 = acc[ai][bj][m][0] * q, v1 = acc[ai][bj][m][1] * q;
                    u32x4 w; w.x = cvt_pk_bf16(v0[0] * G8F(b.x, 0), v0[1] * G8F(b.x, 1)); w.y = cvt_pk_bf16(v0[2] * G8F(b.x, 2), v0[3] * G8F(b.x, 3));
                    w.z = cvt_pk_bf16(v1[0] * G8F(b.y, 0), v1[1] * G8F(b.y, 1)); w.w = cvt_pk_bf16(v1[2] * G8F(b.y, 2), v1[3] * G8F(b.y, 3));
                    *(u32x4*)(O + (size_t)(row0 + ai * HALF + m * 16) * 4096 + col0 + bj * HALF) = w; }
        }
    }
};
struct EpiBf16Plain {
    static constexpr bool PERM = true, AFTER_DRAIN = false; static constexpr int MID_T = -1;
    bf16_t* O; int ldc;
    __device__ __forceinline__ void operator()(const f32x4 (&acc)[2][2][4][2], const Unit& u, int wr, int wc, int fr, int fq) const {
        const int row0 = u.pm * BM + wr * 64 + fr, col0 = u.pn * BM + wc * 32 + 8 * fq;
#pragma unroll
        for (int ai = 0; ai < 2; ++ai)
#pragma unroll
            for (int m = 0; m < 4; ++m) { bf16_t* rowp = O + (size_t)(row0 + ai * HALF + m * 16) * ldc + col0;
#pragma unroll
                for (int bj = 0; bj < 2; ++bj) { const f32x4 v0 = acc[ai][bj][m][0], v1 = acc[ai][bj][m][1];
                    u32x4 w; w.x = cvt_pk_bf16(v0[0], v0[1]); w.y = cvt_pk_bf16(v0[2], v0[3]); w.z = cvt_pk_bf16(v1[0], v1[1]); w.w = cvt_pk_bf16(v1[2], v1[3]);
                    *(u32x4*)(rowp + bj * HALF) = w; } }
    }
};

typedef int i32x4 __attribute__((ext_vector_type(4))); typedef int i32x8 __attribute__((ext_vector_type(8)));
template <class Epi, class Sched, bool ALIGN_EPI = false, bool SP2 = false, bool Q8 = false>
__device__ __forceinline__ void gemm_phase(PG8_LAS unsigned char* lds, const Gemm g, const Sched& S, const Epi& E) {
    const int wid = S.wv, lane = lane_now(), tid = wid * 64 + lane, wr = wid >> 2, wc = wid & 3, fr = lane & 15, fq = lane >> 4;
    const int K = g.K, nt = K / BK;
    unsigned voffA[2], voffB[2];
#pragma unroll
    for (int i = 0; i < 2; ++i) { int R, C; stage_rc(tid * 16 + i * 8192, R, C); const int Rb = Epi::PERM ? ((R & ~31) + perm32(R & 31)) : R;
        voffA[i] = (unsigned)(R * K + C) * 2u; voffB[i] = (unsigned)(Rb * K + C) * 2u; }
    const size_t kstep = (size_t)(BK * 2);
    const size_t hstep = (size_t)HALF * K * 2;
    const size_t tstep = 2 * hstep;
    const unsigned ldsb = (unsigned)(__UINTPTR_TYPE__)lds;
    const unsigned ldsw = (unsigned)wid * 1024u;
    const int aoff = lds_byte(wr * 64 + fr, fq * 8), boff = lds_byte(wc * 32 + fr, fq * 8);
#define PG8_SA(b, h) (((b) * 2 + (h)) * HTB)
#define PG8_SB(b, h) ((4 + (b) * 2 + (h)) * HTB)
#define PG8_STAGE(bufoff, gbase, voff) do { _Pragma("unroll") for (int _i = 0; _i < 2; ++_i) { const unsigned _m0 = ldsb + (unsigned)(bufoff) + ldsw + (unsigned)_i * 8192u; \
        asm volatile("s_mov_b32 m0, %2\n\ts_nop 0\n\tglobal_load_lds_dwordx4 %0, %1" :: "v"((voff)[_i]), "s"((const char*)(gbase)), "s"(_m0) : "m0", "memory"); } } while (0)
#define PG8_LDA(dst, b, h) do { _Pragma("unroll") for (int m = 0; m < 4; ++m) _Pragma("unroll") for (int k = 0; k < 2; ++k) dst[m][k] = *(const PG8_LAS bf16x8*)(lds + PG8_SA(b, h) + aoff + m * 2048 + k * 1024); } while (0)
#define PG8_LDB(dst, b, h) do { _Pragma("unroll") for (int n = 0; n < 2; ++n) _Pragma("unroll") for (int k = 0; k < 2; ++k) dst[n][k] = *(const PG8_LAS bf16x8*)(lds + PG8_SB(b, h) + boff + n * 2048 + k * 1024); } while (0)
#define PG8_MMA(ai, bj, At, Bt) do { __builtin_amdgcn_s_setprio(1); _Pragma("unroll") for (int m = 0; m < 4; ++m) _Pragma("unroll") for (int n = 0; n < 2; ++n) { \
        if constexpr (Q8) { _Pragma("unroll") for (int k = 0; k < 2; ++k) acc[ai][bj][m][n] = __builtin_bit_cast(f32x4, __builtin_amdgcn_mfma_i32_16x16x64_i8(__builtin_bit_cast(i32x4, Bt[n][k]), __builtin_bit_cast(i32x4, At[m][k]), __builtin_bit_cast(i32x4, acc[ai][bj][m][n]), 0, 0, 0)); } \
        else { _Pragma("unroll") for (int k = 0; k < 2; ++k) acc[ai][bj][m][n] = __builtin_amdgcn_mfma_f32_16x16x32_bf16(Bt[n][k], At[m][k], acc[ai][bj][m][n], 0, 0, 0); } } \
        __builtin_amdgcn_s_setprio(0); } while (0)
#define PG8_WAIT_V(n) asm volatile("s_waitcnt vmcnt(" #n ")" ::: "memory")
#define PG8_WAIT_L(n) asm volatile("s_waitcnt lgkmcnt(" #n ")" ::: "memory")
#define PG8_BAR __builtin_amdgcn_s_barrier()
#define PG8_SCHED __builtin_amdgcn_sched_barrier(0)
    Unit cur, nxt; int ui = 0;
    if (!S.next(0, cur)) return;
    f32x4 acc[2][2][4][2];
#pragma unroll
    for (int a = 0; a < 2; ++a)
#pragma unroll
        for (int b = 0; b < 2; ++b)
#pragma unroll
            for (int m = 0; m < 4; ++m)
#pragma unroll
                for (int n = 0; n < 2; ++n) acc[a][b][m][n] = (f32x4){0.f, 0.f, 0.f, 0.f};
    bf16x8 At[4][2], B0[2][2], B1[2][2];
    const char* cA = (const char*)g.A + (size_t)cur.pm * tstep; const char* cB = (const char*)g.Bt + (size_t)cur.pn * tstep;
    S.a_ready(cur);
    if constexpr (SP2) {
        PG8_STAGE(PG8_SB(0, 0), cB, voffB); PG8_STAGE(PG8_SB(0, 1), cB + hstep, voffB); PG8_STAGE(PG8_SA(0, 0), cA, voffA); PG8_STAGE(PG8_SA(0, 1), cA + hstep, voffA);
        if (wr == 1) PG8_BAR;
        PG8_WAIT_V(2); PG8_BAR;
        PG8_STAGE(PG8_SB(1, 0), cB + kstep, voffB); PG8_STAGE(PG8_SA(1, 0), cA + kstep, voffA); PG8_STAGE(PG8_SB(1, 1), cB + hstep + kstep, voffB);
        PG8_WAIT_V(6); PG8_BAR;
    } else {
        PG8_STAGE(PG8_SB(0, 0), cB, voffB); PG8_STAGE(PG8_SA(0, 0), cA, voffA); PG8_STAGE(PG8_SB(0, 1), cB + hstep, voffB); PG8_STAGE(PG8_SA(0, 1), cA + hstep, voffA);
        if (wr == 1) PG8_BAR;
        PG8_WAIT_V(4); PG8_BAR;
        PG8_STAGE(PG8_SB(1, 0), cB + kstep, voffB); PG8_STAGE(PG8_SA(1, 0), cA + kstep, voffA); PG8_STAGE(PG8_SB(1, 1), cB + hstep + kstep, voffB);
        PG8_WAIT_V(6); PG8_BAR;
    }
    for (;;) {
        const bool has_next = S.next(ui + 1, nxt);
        const char* nA = has_next ? (const char*)g.A + (size_t)nxt.pm * tstep : cA; const char* nB = has_next ? (const char*)g.Bt + (size_t)nxt.pn * tstep : cB;
        for (int t = 0; t < nt; t += 2) {
            if constexpr (Epi::MID_T >= 0) { if (t == Epi::MID_T) E.mid(acc, cur, wr, wc, fr, fq); }
            const bool last = (t == nt - 2);
            const char* a1 = cA + (size_t)(t + 1) * kstep;
            const char* a2 = last ? nA : cA + (size_t)(t + 2) * kstep; const char* b2 = last ? nB : cB + (size_t)(t + 2) * kstep;
            const char* a3 = a2 + kstep; const char* b3 = b2 + kstep;
            if (last && has_next) S.a_ready(nxt);
            if constexpr (SP2) {
            PG8_LDB(B0, 0, 0); PG8_LDB(B1, 0, 1); PG8_SCHED; PG8_LDA(At, 0, 0); PG8_STAGE(PG8_SA(1, 1), a1 + hstep, voffA);
            PG8_WAIT_V(8); PG8_WAIT_L(0); PG8_BAR; PG8_MMA(0, 0, At, B0); PG8_MMA(0, 1, At, B1); PG8_BAR; PG8_SCHED;
            PG8_LDA(At, 0, 1); PG8_STAGE(PG8_SB(0, 0), b2, voffB); PG8_STAGE(PG8_SB(0, 1), b2 + hstep, voffB); PG8_STAGE(PG8_SA(0, 0), a2, voffA);
            PG8_WAIT_V(8); PG8_WAIT_L(0); PG8_BAR; PG8_MMA(1, 0, At, B0); PG8_MMA(1, 1, At, B1); PG8_BAR; PG8_SCHED;
            PG8_LDB(B0, 1, 0); PG8_LDB(B1, 1, 1); PG8_SCHED; PG8_LDA(At, 1, 0); PG8_STAGE(PG8_SA(0, 1), a2 + hstep, voffA);
            PG8_WAIT_V(8); PG8_WAIT_L(0); PG8_BAR; PG8_MMA(0, 0, At, B0); PG8_MMA(0, 1, At, B1); PG8_BAR; PG8_SCHED;
            PG8_LDA(At, 1, 1); PG8_STAGE(PG8_SB(1, 0), b3, voffB); PG8_STAGE(PG8_SB(1, 1), b3 + hstep, voffB); PG8_STAGE(PG8_SA(1, 0), a3, voffA);
            PG8_WAIT_V(8); PG8_WAIT_L(0); PG8_BAR; PG8_MMA(1, 0, At, B0); PG8_MMA(1, 1, At, B1); PG8_BAR; PG8_SCHED;
            } else {
            PG8_LDB(B0, 0, 0); PG8_SCHED; PG8_LDA(At, 0, 0); PG8_STAGE(PG8_SA(1, 1), a1 + hstep, voffA);
            PG8_WAIT_L(8); PG8_BAR; PG8_WAIT_L(0); PG8_MMA(0, 0, At, B0); PG8_BAR; PG8_SCHED;
            PG8_LDB(B1, 0, 1); PG8_STAGE(PG8_SB(0, 0), b2, voffB);
            PG8_BAR; PG8_WAIT_L(0); PG8_MMA(0, 1, At, B1); PG8_BAR;
            PG8_LDA(At, 0, 1); PG8_STAGE(PG8_SA(0, 0), a2, voffA);
            PG8_BAR; PG8_WAIT_L(0); PG8_MMA(1, 0, At, B0); PG8_BAR; PG8_SCHED;
            PG8_STAGE(PG8_SB(0, 1), b2 + hstep, voffB);
            PG8_WAIT_V(6); PG8_BAR; PG8_MMA(1, 1, At, B1); PG8_BAR;
            PG8_LDB(B0, 1, 0); PG8_SCHED; PG8_LDA(At, 1, 0); PG8_STAGE(PG8_SA(0, 1), a2 + hstep, voffA);
            PG8_WAIT_L(8); PG8_BAR; PG8_WAIT_L(0); PG8_MMA(0, 0, At, B0); PG8_BAR; PG8_SCHED;
            PG8_LDB(B1, 1, 1); PG8_STAGE(PG8_SB(1, 0), b3, voffB);
            PG8_BAR; PG8_WAIT_L(0); PG8_MMA(0, 1, At, B1); PG8_BAR;
            PG8_LDA(At, 1, 1); PG8_STAGE(PG8_SA(1, 0), a3, voffA);
            PG8_BAR; PG8_WAIT_L(0); PG8_MMA(1, 0, At, B0); PG8_BAR; PG8_SCHED;
            PG8_STAGE(PG8_SB(1, 1), b3 + hstep, voffB);
            PG8_WAIT_V(6); PG8_BAR; PG8_MMA(1, 1, At, B1); PG8_BAR;
            }
        }
        if constexpr (ALIGN_EPI) { if (wr == 0) PG8_BAR; }
        if constexpr (!Epi::AFTER_DRAIN) { const int lz = lane_now();
            E(acc, cur, wr, wc, lz & 15, lz >> 4); S.done(cur); }
        if (!has_next) break;
#pragma unroll
        for (int a = 0; a < 2; ++a)
#pragma unroll
            for (int b = 0; b < 2; ++b)
#pragma unroll
                for (int m = 0; m < 4; ++m)
#pragma unroll
                    for (int n = 0; n < 2; ++n) acc[a][b][m][n] = (f32x4){0.f, 0.f, 0.f, 0.f};
        cur = nxt; cA = nA; cB = nB; ++ui;
        if constexpr (ALIGN_EPI) { if (wr == 1) PG8_BAR; }
    }
    PG8_WAIT_V(0);
    if constexpr (!ALIGN_EPI) { if (wr == 0) PG8_BAR; }
    PG8_BAR;
    if constexpr (Epi::AFTER_DRAIN) { E.fused(acc, cur, wr, wc, fr, fq, lds, wid, lane); S.done(cur); }
#undef PG8_SA
#undef PG8_SB
#undef PG8_STAGE
#undef PG8_LDA
#undef PG8_LDB
#undef PG8_MMA
#undef PG8_WAIT_V
#undef PG8_WAIT_L
#undef PG8_BAR
#undef PG8_SCHED
}
}

#ifndef MK_N_LAUNCHES
#define MK_N_LAUNCHES 1
#endif
static_assert(MK_N_LAUNCHES == 1, "P0 carries a grid barrier inside: one-launch build only");
constexpr int BATCH = 2, SEQ = 8192, D = 4096, DFF = 11008, M = BATCH * SEQ;
constexpr int DH = 2048, NH = 16, HD = 128;
constexpr int NIN = 22528, NUP = 2 * DFF;
constexpr int NPROJ = (7 - NQ8S) * 2048, NGATE = NQ8S * 2048 + 8192;
__host__ __device__ constexpr int win_src_bf(int d) { return bf_seg(d >> 11) * 2048 + (d & 2047); }
__host__ __device__ constexpr int win_src_q8(int d) { return d < NQ8S * 2048 ? q8_seg(d >> 11) * 2048 + (d & 2047) : 14336 + (d - NQ8S * 2048); }
constexpr float NORM_EPS = 1e-6f;
constexpr int NWAVES = 8;
constexpr int NPHASE = 14;

constexpr size_t MiB = 1u << 20;
constexpr size_t WS_CTL = 0, CTL_ZERO_BYTES = 65536;
constexpr size_t WS_CMD1 = 32768, WS_CMD2 = 49152;
constexpr size_t WS_SAH = 1 * MiB + 524288;
constexpr size_t WS_HQ = 1502 * MiB;
constexpr size_t WS_CM1 = 65536, WS_CM2 = WS_CM1 + (size_t)2 * DFF * 4, WS_CMG = WS_CM2 + (size_t)2 * DFF * 4;
constexpr size_t WS_SA1 = 1 * MiB + 262144, WS_SA2 = WS_SA1 + 65536, WS_SAG = WS_SA2 + 65536;
constexpr size_t WS_LB = 1 * MiB;
constexpr size_t WS_DSEG = 1 * MiB + 65536;
constexpr size_t WS_SEND = 2 * MiB;
constexpr size_t WS_W13_1 = 18 * MiB, WS_W2_1 = 190 * MiB, WS_W13_2 = 276 * MiB, WS_W2_2 = 448 * MiB;
constexpr size_t WS_WIN = 534 * MiB, WS_WUA = 710 * MiB, WS_WUB = 726 * MiB, WS_WO = 742 * MiB;
constexpr size_t WS_XN = 774 * MiB;
constexpr size_t WS_YAB = WS_XN;
constexpr size_t WS_Y = 902 * MiB;
constexpr size_t WS_F = WS_Y, WS_QA = WS_Y + 128 * MiB, WS_IA = WS_Y + 192 * MiB, WS_T = WS_Y;
constexpr size_t WS_BIG = 1158 * MiB;
constexpr size_t WS_HID = WS_BIG, WS_GA = WS_BIG, WS_QB = WS_BIG + 64 * MiB, WS_KB = WS_BIG + 128 * MiB, WS_VB = WS_BIG + 192 * MiB, WS_GTA = WS_BIG + 256 * MiB, WS_GTB = WS_BIG + 384 * MiB;
constexpr size_t WS_MX = WS_BIG;
constexpr size_t WS_W2R2 = 1674 * MiB;
constexpr size_t WS_END = 1760 * MiB;
static_assert(WS_W13_1 + (size_t)NUP * D * 2 == WS_W2_1 && WS_W2_1 + (size_t)D * DFF * 2 == WS_W13_2 && WS_W13_2 + (size_t)NUP * D * 2 == WS_W2_2 && WS_W2_2 + (size_t)D * DFF * 2 == WS_WIN, "ws map (ffn weights)");
static_assert(WS_WIN + (size_t)NIN * D * 2 == WS_WUA && WS_WUA + (size_t)D * DH * 2 == WS_WUB && WS_WUB + (size_t)D * DH * 2 == WS_WO && WS_WO + (size_t)D * D * 2 == WS_XN, "ws map (mixer weights)");
static_assert(WS_XN + (size_t)M * D * 2 == WS_Y && WS_Y + (size_t)M * D * 4 == WS_BIG && WS_HID + (size_t)M * DFF * 2 == WS_HQ && WS_HQ + (size_t)M * DFF == WS_W2R2 && WS_W2R2 + (size_t)D * DFF * 2 == WS_END && WS_GTB + (size_t)M * D * 2 <= WS_HQ + 168 * MiB, "ws map (activations)");
constexpr int CW_BAR = 4096;

constexpr int RING_OFF = 0, RING_BYTES = 131072;
constexpr int LDSCTL_OFF = RING_BYTES, MISC_OFF = LDSCTL_OFF + 320;
constexpr int LDS_BYTES = 147456;

#define GAS __attribute__((address_space(1)))
#define LAS __attribute__((address_space(3)))
typedef unsigned short bf16;
typedef unsigned v4u __attribute__((ext_vector_type(4)));
typedef unsigned v2u __attribute__((ext_vector_type(2)));
typedef float f32x4 __attribute__((ext_vector_type(4)));
typedef float f32x16 __attribute__((ext_vector_type(16)));
typedef short bf16x8 __attribute__((ext_vector_type(8)));
typedef short s16x4 __attribute__((ext_vector_type(4)));
typedef GAS unsigned gu32;
#define RLX_AGENT __ATOMIC_RELAXED, __HIP_MEMORY_SCOPE_AGENT
#define LDS_WAIT() asm volatile("s_waitcnt lgkmcnt(0)" ::: "memory")
#define VM_WAIT() asm volatile("s_waitcnt vmcnt(0)" ::: "memory")
__device__ __forceinline__ unsigned f2bf(float f) { unsigned u = __builtin_bit_cast(unsigned, f); return (u + 0x7fffu + ((u >> 16) & 1u)) >> 16; }
__device__ __forceinline__ unsigned pk2(float lo, float hi) { return pg8::cvt_pk_bf16(lo, hi); }
__device__ __forceinline__ float bflo(unsigned u) { return __uint_as_float(u << 16); }
__device__ __forceinline__ float bfhi(unsigned u) { return __uint_as_float(u & 0xffff0000u); }
#define XB_TMO      128
#define XB_XCNT(j)  (256  + 64 * (j))
#define XB_XSUB(j)  (1280 + 64 * (j))
#define XB_XGEN(j)  (2304 + 64 * (j))
#define XB_TOP      3328
#define XB_TOPGEN   3392
#define XCD_BAR_WORDS 3456
#define XB_SPIN_CAP (1u << 18)

__device__ __forceinline__ unsigned xb_ld(unsigned* p)              { return __hip_atomic_load(p, __ATOMIC_RELAXED, __HIP_MEMORY_SCOPE_AGENT); }
__device__ __forceinline__ unsigned xb_add(unsigned* p, unsigned v) { return __hip_atomic_fetch_add(p, v, __ATOMIC_RELAXED, __HIP_MEMORY_SCOPE_AGENT); }
__device__ __forceinline__ unsigned xb_xcc_id() { return (unsigned)__builtin_amdgcn_s_getreg((3 << 11) | 20) & 0xFu; }
#define XB_SPIN(cond, bar) do { unsigned _sp = 0; while (cond) { __builtin_amdgcn_s_sleep(1); \
    if ((++_sp & 255u) == 0u) { if (xb_ld(&(bar)[XB_TMO])) break; if (_sp > XB_SPIN_CAP) { atomicAdd(&(bar)[XB_TMO], 1u); break; } } } } while (0)

struct XcdBarrier {
    unsigned* bar; unsigned x;
    volatile LAS unsigned* st;
    bool w0;
};

__device__ __forceinline__ XcdBarrier xcd_barrier_post(unsigned* bar, volatile LAS unsigned* st, bool w0) {
    XcdBarrier b; b.bar = bar; b.x = xb_xcc_id(); b.st = st; b.w0 = w0;
    if (w0 && lane_now() == 0) (void)xb_add(&bar[XB_XCNT(b.x)], 1u);
    return b;
}
__device__ __forceinline__ void xcd_barrier_complete(unsigned* bar, unsigned x, unsigned& nloc, unsigned& nx) {
    const unsigned G = gridDim.x * gridDim.y * gridDim.z;
    unsigned sum, cnt, mine, sp = 0u;
    for (;;) {
        sum = 0u; cnt = 0u; mine = 0u;
#pragma unroll
        for (unsigned j = 0; j < 16; ++j) { const unsigned c = xb_ld(&bar[XB_XCNT(j)]); sum += c; cnt += (c > 0u) ? 1u : 0u; mine = (j == x) ? c : mine; }
        if (sum == G) break;
        __builtin_amdgcn_s_sleep(1);
        if ((++sp & 255u) == 0u) { if (xb_ld(&bar[XB_TMO])) break; if (sp > XB_SPIN_CAP) { atomicAdd(&bar[XB_TMO], 1u); break; } }
    }
    nloc = mine > 0u ? mine : 1u; nx = cnt > 0u ? cnt : 1u;
}

__device__ __forceinline__ void xcd_barrier(const XcdBarrier& b) {
    asm volatile("s_waitcnt vmcnt(0)" ::: "memory");
    __syncthreads();
    if (b.w0 && lane_now() == 0) {
        unsigned* bar = b.bar;
        __builtin_amdgcn_s_waitcnt(0);
        unsigned nloc = b.st[0], nx = b.st[1];
        if (nloc == 0u) { xcd_barrier_complete(bar, b.x, nloc, nx); b.st[0] = nloc; b.st[1] = nx; }
        const unsigned old = xb_add(&bar[XB_XSUB(b.x)], 1u);
        const unsigned gen = old / nloc;
        if (old + 1u == (gen + 1u) * nloc) {
            __builtin_amdgcn_fence(__ATOMIC_RELEASE, "agent");
            asm volatile("s_waitcnt vmcnt(0)" ::: "memory");
            const unsigned og = xb_add(&bar[XB_TOP], 1u);
            const unsigned tg = og / nx;
            if (og + 1u == (tg + 1u) * nx) xb_add(&bar[XB_TOPGEN], 1u);
            else XB_SPIN(xb_ld(&bar[XB_TOPGEN]) == tg, bar);
            __builtin_amdgcn_fence(__ATOMIC_ACQUIRE, "agent");
            xb_add(&bar[XB_XGEN(b.x)], 1u);
            asm volatile("s_waitcnt vmcnt(0)" ::: "memory");
        } else {
            XB_SPIN(xb_ld(&bar[XB_XGEN(b.x)]) == gen, bar);
            __builtin_amdgcn_fence(__ATOMIC_ACQUIRE, "agent");
            asm volatile("s_waitcnt vmcnt(0)" ::: "memory");
        }
    }
    __syncthreads();
}


__device__ __forceinline__ float wave_sum(float v) {
#pragma unroll
    for (int o = 1; o < 64; o <<= 1) v += __shfl_xor(v, o);
    return v;
}
__device__ __forceinline__ void tr_item(const float* __restrict__ W, int K, int N, bf16* __restrict__ WT, int k0, int n0, int dst_row0, LAS float* scr, int lane, int kd0 = -1) {
    if (kd0 < 0) kd0 = k0;
#pragma unroll 8
    for (int i = 0; i < 32; ++i) { const int kk = 2 * i + (lane >> 5); scr[kk * 33 + (lane & 31)] = W[(size_t)(k0 + kk) * N + n0 + (lane & 31)]; }
    LDS_WAIT(); asm volatile("" ::: "memory");
    const int c = lane & 7;
#pragma unroll
    for (int j = 0; j < 4; ++j) { const int n = (lane >> 3) + 8 * j; const LAS float* s = scr + (8 * c) * 33 + n;
        v4u o; o.x = pk2(s[0 * 33], s[1 * 33]); o.y = pk2(s[2 * 33], s[3 * 33]); o.z = pk2(s[4 * 33], s[5 * 33]); o.w = pk2(s[6 * 33], s[7 * 33]);
        *(GAS v4u*)(WT + (size_t)(dst_row0 + n) * K + kd0 + 8 * c) = o; }
    LDS_WAIT(); asm volatile("" ::: "memory");
}
__device__ __forceinline__ void tr_plain(const float* W, int K, int N, bf16* WT, int r, LAS float* scr, int lane) {
    const int nblk = N / 32, kb = r / nblk, nb = r % nblk; tr_item(W, K, N, WT, 64 * kb, 32 * nb, 32 * nb, scr, lane);
}
__device__ __forceinline__ void tr_glu(const float* W, bf16* WT, int half, int r, LAS float* scr, int lane) {
    const int nblk = DFF / 32, kb = r / nblk, nb = r % nblk, n0 = 32 * nb; tr_item(W, D, DFF, WT, 64 * kb, n0, 256 * (n0 >> 7) + (n0 & 127) + 128 * half, scr, lane);
}
__device__ __forceinline__ float wave_max(float v) {
#pragma unroll
    for (int o = 1; o < 64; o <<= 1) v = fmaxf(v, __shfl_xor(v, o));
    return v;
}
__device__ __forceinline__ int q8(float x) { return (int)__builtin_rintf(x); }
__device__ __forceinline__ unsigned pk4_i8(float a, float b, float c, float d) {
    const float MG = 12582912.0f;
    const unsigned ua = __float_as_uint(a + MG), ub = __float_as_uint(b + MG), uc = __float_as_uint(c + MG), ud = __float_as_uint(d + MG);
    return __builtin_amdgcn_perm(ub, ua, 0x0c0c0400u) | (__builtin_amdgcn_perm(ud, uc, 0x0c0c0400u) << 16);
}
__device__ __forceinline__ void wg_q8_item(const float* __restrict__ W, int N, int n0, unsigned char* __restrict__ WT8, int dst_row0, float* CM, LAS unsigned char* lds, int wave, int lane) {
    LAS float* scr = (LAS float*)(lds + wave * 16384);
    LAS float* cmL = (LAS float*)(lds + 12288);
    LAS float* cfin = cmL + 256;
    {   f32x4 mx = (f32x4){0.f, 0.f, 0.f, 0.f};
        const float* src = W + (size_t)(512 * wave + (lane >> 3)) * N + n0 + 4 * (lane & 7);
#pragma unroll 8
        for (int r = 0; r < 64; ++r) { const f32x4 v = *(const GAS f32x4*)(src + (size_t)(8 * r) * N);
            mx.x = fmaxf(mx.x, fabsf(v.x)); mx.y = fmaxf(mx.y, fabsf(v.y)); mx.z = fmaxf(mx.z, fabsf(v.z)); mx.w = fmaxf(mx.w, fabsf(v.w)); }
#pragma unroll
        for (int o = 8; o < 64; o <<= 1) { mx.x = fmaxf(mx.x, __shfl_xor(mx.x, o)); mx.y = fmaxf(mx.y, __shfl_xor(mx.y, o)); mx.z = fmaxf(mx.z, __shfl_xor(mx.z, o)); mx.w = fmaxf(mx.w, __shfl_xor(mx.w, o)); }
        if (lane < 8) *(LAS f32x4*)(cmL + wave * 32 + 4 * lane) = mx; }
    __syncthreads();
    if (wave == 0 && lane < 32) { float c = cmL[lane];
#pragma unroll
        for (int w = 1; w < 8; ++w) c = fmaxf(c, cmL[w * 32 + lane]);
        cfin[lane] = c; CM[dst_row0 + lane] = c; }
    __syncthreads();
    const int c8 = lane & 7;
    float inv[4];
#pragma unroll
    for (int j = 0; j < 4; ++j) { const float cmv = cfin[(lane >> 3) + 8 * j]; inv[j] = cmv > 0.f ? 127.0f / cmv : 0.f; }
    for (int ch = 0; ch < 8; ++ch) {
        const int k0 = 512 * wave + 64 * ch;
#pragma unroll 8
        for (int i = 0; i < 32; ++i) { const int kk = 2 * i + (lane >> 5); scr[kk * 33 + (lane & 31)] = W[(size_t)(k0 + kk) * N + n0 + (lane & 31)]; }
        LDS_WAIT(); asm volatile("" ::: "memory");
#pragma unroll
        for (int j = 0; j < 4; ++j) { const int n = (lane >> 3) + 8 * j; const LAS float* sp = scr + (8 * c8) * 33 + n;
            v2u o; o.x = pk4_i8(sp[0 * 33] * inv[j], sp[1 * 33] * inv[j], sp[2 * 33] * inv[j], sp[3 * 33] * inv[j]); o.y = pk4_i8(sp[4 * 33] * inv[j], sp[5 * 33] * inv[j], sp[6 * 33] * inv[j], sp[7 * 33] * inv[j]);
            *(GAS v2u*)(WT8 + (size_t)(dst_row0 + n) * 4096 + k0 + 8 * c8) = o; }
        LDS_WAIT(); asm volatile("" ::: "memory");
    }
    __syncthreads();
}
template <bool QUANT>
__device__ __forceinline__ void w2_had_item(const float* __restrict__ W, unsigned char* __restrict__ WT8, unsigned* CMX, int r, LAS float* scr, int lane, int nb0 = 0, int nblk = D / 32) {
    const int kb = r / nblk, nb = nb0 + r % nblk, k0 = 64 * kb, n0 = 32 * nb;
    float inv[4];
    if constexpr (QUANT) {
#pragma unroll
        for (int j = 0; j < 4; ++j) { const float cmv = __uint_as_float(CMX[n0 + (lane >> 3) + 8 * j]); inv[j] = cmv > 0.f ? 127.0f / cmv : 0.f; }
    }
#pragma unroll 8
    for (int i = 0; i < 32; ++i) { const int kk = 2 * i + (lane >> 5); scr[kk * 33 + (lane & 31)] = W[(size_t)(k0 + kk) * D + n0 + (lane & 31)]; }
    LDS_WAIT(); asm volatile("" ::: "memory");
    const int c = lane & 7;
#pragma unroll
    for (int j = 0; j < 4; ++j) { const int n = (lane >> 3) + 8 * j; const LAS float* sp = scr + (8 * c) * 33 + n;
        float v[8];
#pragma unroll
        for (int i = 0; i < 8; ++i) v[i] = sp[i * 33];
        wht8(v); wht_q<0xB1>(v, 1, lane); wht_q<0x4E>(v, 2, lane);
        if constexpr (!QUANT) {
            float mx = fmaxf(fmaxf(fmaxf(fabsf(v[0]), fabsf(v[1])), fmaxf(fabsf(v[2]), fabsf(v[3]))), fmaxf(fmaxf(fabsf(v[4]), fabsf(v[5])), fmaxf(fabsf(v[6]), fabsf(v[7]))));
            mx = fmaxf(mx, dpp_f<0xB1>(mx)); mx = fmaxf(mx, dpp_f<0x4E>(mx)); mx = fmaxf(mx, dpp_f<0x104>(mx));
            if (c == 0) (void)__hip_atomic_fetch_max(CMX + n0 + n, __float_as_uint(mx), RLX_AGENT);
        } else {
            const float iv = inv[j];
            v2u o; o.x = pk4_i8(v[0] * iv, v[1] * iv, v[2] * iv, v[3] * iv); o.y = pk4_i8(v[4] * iv, v[5] * iv, v[6] * iv, v[7] * iv);
            *(GAS v2u*)(WT8 + (size_t)(n0 + n) * DFF + k0 + 8 * c) = o; }
    }
    LDS_WAIT(); asm volatile("" ::: "memory");
}
template <bool QUANT>
__device__ __forceinline__ void w2_had_stream(const float* __restrict__ W, unsigned char* __restrict__ WT8, unsigned* CMX, int it0, int step, int nit, LAS float* scr, int lane, int nblk) {
    float v[32]; float cmn[4] = {0.f, 0.f, 0.f, 0.f};
    if (it0 < nit) { const int kb = it0 / nblk, nb = it0 % nblk; const float* src = W + (size_t)(64 * kb + (lane >> 5)) * D + 32 * nb + (lane & 31);
#pragma unroll
        for (int i = 0; i < 32; ++i) v[i] = src[(size_t)(2 * i) * D];
        if constexpr (QUANT) {
#pragma unroll
            for (int j = 0; j < 4; ++j) cmn[j] = __uint_as_float(CMX[32 * nb + (lane >> 3) + 8 * j]); } }
    for (int it = it0; it < nit; it += step) {
        const int kb = it / nblk, nb = it % nblk, k0 = 64 * kb, n0 = 32 * nb;
#pragma unroll
        for (int i = 0; i < 32; ++i) scr[(2 * i + (lane >> 5)) * 33 + (lane & 31)] = v[i];
        float inv[4];
#pragma unroll
        for (int j = 0; j < 4; ++j) inv[j] = cmn[j] > 0.f ? 127.0f / cmn[j] : 0.f;
        const int nx = it + step;
        if (nx < nit) { const int kb2 = nx / nblk, nb2 = nx % nblk; const float* src = W + (size_t)(64 * kb2 + (lane >> 5)) * D + 32 * nb2 + (lane & 31);
#pragma unroll
            for (int i = 0; i < 32; ++i) v[i] = src[(size_t)(2 * i) * D];
            if constexpr (QUANT) {
#pragma unroll
                for (int j = 0; j < 4; ++j) cmn[j] = __uint_as_float(CMX[32 * nb2 + (lane >> 3) + 8 * j]); } }
        LDS_WAIT(); asm volatile("" ::: "memory");
        const int c = lane & 7;
#pragma unroll
        for (int j = 0; j < 4; ++j) { const int n = (lane >> 3) + 8 * j; const LAS float* sp = scr + (8 * c) * 33 + n;
            float t[8];
#pragma unroll
            for (int i = 0; i < 8; ++i) t[i] = sp[i * 33];
            wht8(t); wht_q<0xB1>(t, 1, lane); wht_q<0x4E>(t, 2, lane);
            if constexpr (!QUANT) {
                float mx = fmaxf(fmaxf(fmaxf(fabsf(t[0]), fabsf(t[1])), fmaxf(fabsf(t[2]), fabsf(t[3]))), fmaxf(fmaxf(fabsf(t[4]), fabsf(t[5])), fmaxf(fabsf(t[6]), fabsf(t[7]))));
                mx = fmaxf(mx, dpp_f<0xB1>(mx)); mx = fmaxf(mx, dpp_f<0x4E>(mx)); mx = fmaxf(mx, dpp_f<0x104>(mx));
                if (c == 0) (void)__hip_atomic_fetch_max(CMX + n0 + n, __float_as_uint(mx), RLX_AGENT);
            } else {
                const float iv = inv[j];
                v2u o; o.x = pk4_i8(t[0] * iv, t[1] * iv, t[2] * iv, t[3] * iv); o.y = pk4_i8(t[4] * iv, t[5] * iv, t[6] * iv, t[7] * iv);
                *(GAS v2u*)(WT8 + (size_t)(n0 + n) * DFF + k0 + 8 * c) = o; }
        }
        LDS_WAIT(); asm volatile("" ::: "memory");
    }
}
__device__ __forceinline__ void w2_rot_item(const float* __restrict__ W, bf16* __restrict__ W2R, int r, LAS float* scr, int lane) {
    const int nblk = D / 32, kb = r / nblk, nb = r % nblk, k0 = 64 * kb, n0 = 32 * nb;
#pragma unroll 8
    for (int i = 0; i < 32; ++i) { const int kk = 2 * i + (lane >> 5); scr[kk * 33 + (lane & 31)] = W[(size_t)(k0 + kk) * D + n0 + (lane & 31)]; }
    LDS_WAIT(); asm volatile("" ::: "memory");
    const int c = lane & 7;
#pragma unroll
    for (int j = 0; j < 4; ++j) { const int n = (lane >> 3) + 8 * j; const LAS float* sp = scr + (8 * c) * 33 + n;
        float t[8];
#pragma unroll
        for (int i = 0; i < 8; ++i) t[i] = sp[i * 33];
        wht8(t); wht_q<0xB1>(t, 1, lane); wht_q<0x4E>(t, 2, lane);
        v4u o; o.x = pk2(t[0], t[1]); o.y = pk2(t[2], t[3]); o.z = pk2(t[4], t[5]); o.w = pk2(t[6], t[7]);
        *(GAS v4u*)(W2R + (size_t)(n0 + n) * DFF + k0 + 8 * c) = o; }
    LDS_WAIT(); asm volatile("" ::: "memory");
}
__device__ __forceinline__ void hid_row_to_q8(const bf16* hrow, unsigned char* qrow, float* sa, int lane) {
    const GAS v2u* h4 = (const GAS v2u*)hrow + lane; GAS unsigned* o4 = (GAS unsigned*)qrow + lane;
    v2u hv[43];
#pragma unroll
    for (int i = 0; i < 43; ++i) hv[i] = h4[64 * i];
    float am = 0.f;
#pragma unroll
    for (int i = 0; i < 43; ++i) am = fmaxf(fmaxf(am, fmaxf(fabsf(bflo(hv[i].x)), fabsf(bfhi(hv[i].x)))), fmaxf(fabsf(bflo(hv[i].y)), fabsf(bfhi(hv[i].y))));
    am = wave_max(am); const float inv = am > 0.f ? 127.0f / am : 0.f;
    if (lane == 0) *sa = am * (1.0f / 127.0f);
#pragma unroll
    for (int i = 0; i < 43; ++i) { const v2u w = hv[i]; o4[64 * i] = pk4_i8(bflo(w.x) * inv, bfhi(w.x) * inv, bflo(w.y) * inv, bfhi(w.y) * inv); }
}
__device__ __forceinline__ void wg_q8_item_h(const float* __restrict__ W, int N, int n0, unsigned char* __restrict__ WT8, int dst_row0, float* CM, LAS unsigned char* lds, int wave, int lane) {
    LAS float* cmL = (LAS float*)(lds + MISC_OFF + 1024);
    LAS float* cfin = cmL + 256;
    v2u rp[8][4];
    {   f32x4 mx = (f32x4){0.f, 0.f, 0.f, 0.f};
        const int g = lane >> 3, q = lane & 7;
        const float* src = W + (size_t)(512 * wave + 4 * g) * N + n0 + 4 * q;
#pragma unroll 4
        for (int it = 0; it < 8; ++it) {
            f32x4 v[4];
#pragma unroll
            for (int j = 0; j < 4; ++j) v[j] = *(const GAS f32x4*)(src + (size_t)(32 * it + j) * N);
#pragma unroll
            for (int j = 0; j < 4; ++j) { mx.x = fmaxf(mx.x, fabsf(v[j].x)); mx.y = fmaxf(mx.y, fabsf(v[j].y)); mx.z = fmaxf(mx.z, fabsf(v[j].z)); mx.w = fmaxf(mx.w, fabsf(v[j].w)); }
            const int gr = (64 * wave + 8 * it + g) ^ (q << 1);
#pragma unroll
            for (int c = 0; c < 4; ++c) { v2u o; o.x = pg8::cvt_pk_bf16(v[0][c], v[1][c]); o.y = pg8::cvt_pk_bf16(v[2][c], v[3][c]); *(LAS v2u*)(lds + (4 * q + c) * 4096 + gr * 8) = o; }
        }
#pragma unroll
        for (int it = 0; it < 8; ++it) {
            f32x4 v[4];
#pragma unroll
            for (int j = 0; j < 4; ++j) v[j] = *(const GAS f32x4*)(src + (size_t)(256 + 32 * it + j) * N);
#pragma unroll
            for (int j = 0; j < 4; ++j) { mx.x = fmaxf(mx.x, fabsf(v[j].x)); mx.y = fmaxf(mx.y, fabsf(v[j].y)); mx.z = fmaxf(mx.z, fabsf(v[j].z)); mx.w = fmaxf(mx.w, fabsf(v[j].w)); }
#pragma unroll
            for (int c = 0; c < 4; ++c) { rp[it][c].x = pg8::cvt_pk_bf16(v[0][c], v[1][c]); rp[it][c].y = pg8::cvt_pk_bf16(v[2][c], v[3][c]); }
        }
#pragma unroll
        for (int o = 8; o < 64; o <<= 1) { mx.x = fmaxf(mx.x, __shfl_xor(mx.x, o)); mx.y = fmaxf(mx.y, __shfl_xor(mx.y, o)); mx.z = fmaxf(mx.z, __shfl_xor(mx.z, o)); mx.w = fmaxf(mx.w, __shfl_xor(mx.w, o)); }
        if (lane < 8) *(LAS f32x4*)(cmL + wave * 32 + 4 * lane) = mx; }
    __syncthreads();
    if (wave == 0 && lane < 32) { float c = cmL[lane];
#pragma unroll
        for (int w = 1; w < 8; ++w) c = fmaxf(c, cmL[w * 32 + lane]);
        c = bflo(pg8::cvt_pk_bf16(c, c));
        cfin[lane] = c; CM[dst_row0 + lane] = c; }
    __syncthreads();
#pragma unroll
    for (int h = 0; h < 4; ++h) { const int n = 4 * wave + h; const float cmv = cfin[n]; const float inv = cmv > 0.f ? 127.0f / cmv : 0.f;
        const LAS unsigned char* rowp = lds + n * 4096; const int sw = n >> 2;
#pragma unroll
        for (int i = 0; i < 4; ++i) { const int y = lane + 64 * i; const v4u w = *(const LAS v4u*)(rowp + ((y ^ sw) << 4));
            v2u o; o.x = pk4_i8(bflo(w.x) * inv, bfhi(w.x) * inv, bflo(w.y) * inv, bfhi(w.y) * inv); o.y = pk4_i8(bflo(w.z) * inv, bfhi(w.z) * inv, bflo(w.w) * inv, bfhi(w.w) * inv);
            *(GAS v2u*)(WT8 + (size_t)(dst_row0 + n) * 4096 + 512 * (y >> 5) + 8 * (y & 31)) = o; } }
    {   const int g = lane >> 3, q = lane & 7;
#pragma unroll
        for (int c = 0; c < 4; ++c) { const float cmv = cfin[4 * q + c]; const float iv = cmv > 0.f ? 127.0f / cmv : 0.f;
            unsigned char* rowp = WT8 + (size_t)(dst_row0 + 4 * q + c) * 4096 + 512 * wave + 256 + 4 * g;
#pragma unroll
            for (int it = 0; it < 8; ++it) *(GAS unsigned*)(rowp + 32 * it) = pk4_i8(bflo(rp[it][c].x) * iv, bfhi(rp[it][c].x) * iv, bflo(rp[it][c].y) * iv, bfhi(rp[it][c].y) * iv); } }
    __syncthreads();
}
__device__ __forceinline__ void rms_row_to_q8(const float* xrow, const float* g, unsigned char* qrow, float* sa, int lane, bf16* xbrow = nullptr) {
    asm volatile("" : "+s"(g));
    const GAS f32x4* xr = (const GAS f32x4*)xrow + lane; const GAS f32x4* gr = (const GAS f32x4*)g + lane;
    f32x4 v[16]; float s = 0.f;
#pragma unroll
    for (int j = 0; j < 16; ++j) { v[j] = xr[64 * j]; s += (v[j].x * v[j].x + v[j].y * v[j].y) + (v[j].z * v[j].z + v[j].w * v[j].w); }
    if (xbrow != nullptr) { GAS v2u* xb = (GAS v2u*)xbrow + lane;
#pragma unroll
        for (int j = 0; j < 16; ++j) { v2u o; o.x = pk2(v[j].x, v[j].y); o.y = pk2(v[j].z, v[j].w); xb[64 * j] = o; } }
    const float r = 1.0f / sqrtf(wave_sum(s) * (1.f / D) + NORM_EPS);
    float am = 0.f;
#pragma unroll
    for (int j = 0; j < 16; ++j) { const f32x4 gg = gr[64 * j]; v[j].x *= r * gg.x; v[j].y *= r * gg.y; v[j].z *= r * gg.z; v[j].w *= r * gg.w;
        am = fmaxf(am, fmaxf(fmaxf(fabsf(v[j].x), fabsf(v[j].y)), fmaxf(fabsf(v[j].z), fabsf(v[j].w)))); }
    am = wave_max(am); const float inv = am > 0.f ? 127.0f / am : 0.f;
    if (lane == 0) *sa = am * (1.0f / 127.0f);
    GAS unsigned* o4 = (GAS unsigned*)qrow + lane;
#pragma unroll
    for (int j = 0; j < 16; ++j) o4[64 * j] = pk4_i8(v[j].x * inv, v[j].y * inv, v[j].z * inv, v[j].w * inv);
}
__device__ __forceinline__ void rms_row_to_bf16(const float* xrow, const float* __restrict__ g, bf16* orow, int lane) {
    const GAS f32x4* xr = (const GAS f32x4*)xrow + lane; const GAS f32x4* gr = (const GAS f32x4*)g + lane;
    f32x4 v[16]; float s = 0.f;
#pragma unroll
    for (int j = 0; j < 16; ++j) { v[j] = xr[64 * j]; s += (v[j].x * v[j].x + v[j].y * v[j].y) + (v[j].z * v[j].z + v[j].w * v[j].w); }
    const float r = 1.0f / sqrtf(wave_sum(s) * (1.f / D) + NORM_EPS);
    GAS v2u* o8 = (GAS v2u*)orow + lane;
#pragma unroll
    for (int j = 0; j < 16; ++j) { const f32x4 gg = gr[64 * j]; v2u o; o.x = pk2(v[j].x * r * gg.x, v[j].y * r * gg.y); o.y = pk2(v[j].z * r * gg.z, v[j].w * r * gg.w); o8[64 * j] = o; }
}
template <bool HN, bool XI_BF, bool XO_BF, bool HB = true, bool H8 = false> __device__ __forceinline__ void post_row(const bf16* yrow, const void* xi, void* xo, const float* gpost, float wgt, const float* gpre, bf16* hrow, int lane, unsigned char* h8row = nullptr, float* sa = nullptr) {
    asm volatile("" : "+s"(gpost), "+s"(gpre));
    const GAS v4u* yr = (const GAS v4u*)yrow + lane;
    const GAS f32x4* gp = (const GAS f32x4*)gpost + 2 * lane;
    f32x4 v[8][2]; float s = 0.f;
    v4u xb[8]; f32x4 xf[8][2];
#pragma unroll
    for (int j = 0; j < 8; ++j) { if (XI_BF) xb[j] = ((const GAS v4u*)xi + lane)[64 * j]; else { xf[j][0] = ((const GAS f32x4*)xi + 2 * lane)[128 * j]; xf[j][1] = ((const GAS f32x4*)xi + 2 * lane)[128 * j + 1]; } }
#pragma unroll
    for (int j = 0; j < 8; ++j) { const v4u w = yr[64 * j]; v[j][0] = (f32x4){bflo(w.x), bfhi(w.x), bflo(w.y), bfhi(w.y)}; v[j][1] = (f32x4){bflo(w.z), bfhi(w.z), bflo(w.w), bfhi(w.w)};
#pragma unroll
        for (int e = 0; e < 2; ++e) s += (v[j][e].x * v[j][e].x + v[j][e].y * v[j][e].y) + (v[j][e].z * v[j][e].z + v[j][e].w * v[j][e].w); }
    const float r = wgt / sqrtf(wave_sum(s) * (1.f / D) + NORM_EPS);
    float s2 = 0.f;
#pragma unroll
    for (int j = 0; j < 8; ++j) {
        f32x4 xx[2];
        if (XI_BF) { const v4u w = xb[j]; xx[0] = (f32x4){bflo(w.x), bfhi(w.x), bflo(w.y), bfhi(w.y)}; xx[1] = (f32x4){bflo(w.z), bfhi(w.z), bflo(w.w), bfhi(w.w)}; }
        else { xx[0] = xf[j][0]; xx[1] = xf[j][1]; }
#pragma unroll
        for (int e = 0; e < 2; ++e) { const f32x4 gg = gp[128 * j + e];
            v[j][e].x = xx[e].x + v[j][e].x * r * gg.x; v[j][e].y = xx[e].y + v[j][e].y * r * gg.y; v[j][e].z = xx[e].z + v[j][e].z * r * gg.z; v[j][e].w = xx[e].w + v[j][e].w * r * gg.w;
            s2 += (v[j][e].x * v[j][e].x + v[j][e].y * v[j][e].y) + (v[j][e].z * v[j][e].z + v[j][e].w * v[j][e].w); }
        if (XO_BF) { v4u o; o.x = pk2(v[j][0].x, v[j][0].y); o.y = pk2(v[j][0].z, v[j][0].w); o.z = pk2(v[j][1].x, v[j][1].y); o.w = pk2(v[j][1].z, v[j][1].w); ((GAS v4u*)xo + lane)[64 * j] = o; }
        else { ((GAS f32x4*)xo + 2 * lane)[128 * j] = v[j][0]; ((GAS f32x4*)xo + 2 * lane)[128 * j + 1] = v[j][1]; }
    }
    if (HN) {
        const float r2 = 1.0f / sqrtf(wave_sum(s2) * (1.f / D) + NORM_EPS);
        const GAS f32x4* gq = (const GAS f32x4*)gpre + 2 * lane; float am = 0.f;
#pragma unroll
        for (int j = 0; j < 8; ++j)
#pragma unroll
            for (int e = 0; e < 2; ++e) { const f32x4 gg = gq[128 * j + e]; v[j][e].x *= r2 * gg.x; v[j][e].y *= r2 * gg.y; v[j][e].z *= r2 * gg.z; v[j][e].w *= r2 * gg.w;
                if (H8) am = fmaxf(am, fmaxf(fmaxf(fabsf(v[j][e].x), fabsf(v[j][e].y)), fmaxf(fabsf(v[j][e].z), fabsf(v[j][e].w)))); }
        if (HB) { GAS v4u* o16 = (GAS v4u*)hrow + lane;
#pragma unroll
            for (int j = 0; j < 8; ++j) { v4u o; o.x = pk2(v[j][0].x, v[j][0].y); o.y = pk2(v[j][0].z, v[j][0].w); o.z = pk2(v[j][1].x, v[j][1].y); o.w = pk2(v[j][1].z, v[j][1].w); o16[64 * j] = o; } }
        if (H8) { am = wave_max(am); const float inv = am > 0.f ? 127.0f / am : 0.f;
            if (lane == 0) *sa = am * (1.0f / 127.0f);
#pragma unroll
            for (int j = 0; j < 8; ++j) { v2u q; q.x = pk4_i8(v[j][0].x * inv, v[j][0].y * inv, v[j][0].z * inv, v[j][0].w * inv); q.y = pk4_i8(v[j][1].x * inv, v[j][1].y * inv, v[j][1].z * inv, v[j][1].w * inv);
                ((GAS v2u*)h8row + lane)[64 * j] = q; } }
    }
}

constexpr int HG_NSEG = 8, HG_SEGLEN = SEQ / HG_NSEG, HG_TB = 32;
struct HgT { const float* F; const bf16* QA; const bf16* IA; const bf16* GA; const float* normg; float* SEND; float* DSEG; bf16* YA; };
constexpr int AL_K = 0, AL_V = 34816, AL_BT = 69632, A_TILE = 17408, A_RS = 272;
struct AtT { const bf16* QB; const bf16* KB; const bf16* VB; const float* relb; bf16* YB; };
typedef float f32x2_t __attribute__((ext_vector_type(2)));
typedef __bf16 bf16x2_t __attribute__((ext_vector_type(2)));
__device__ __forceinline__ unsigned cvtpk_s(float lo, float hi) { f32x2_t v = {lo, hi}; bf16x2_t b = __builtin_convertvector(v, bf16x2_t); return __builtin_bit_cast(unsigned, b); }
__device__ __forceinline__ bf16x8 pack8(float a0, float a1, float a2, float a3, float a4, float a5, float a6, float a7) {
    v4u w; w.x = cvtpk_s(a0, a1); w.y = cvtpk_s(a2, a3); w.z = cvtpk_s(a4, a5); w.w = cvtpk_s(a6, a7); return __builtin_bit_cast(bf16x8, w);
}
__device__ __forceinline__ s16x4 vtr(const LAS unsigned char* p) { return __builtin_bit_cast(s16x4, __builtin_amdgcn_ds_read_tr16_b64_v4i16((LAS s16x4*)p)); }
__device__ __forceinline__ void attn_item(const AtT& T, LAS unsigned char* lds, int bh, int ib, int tid) {
    const int w = __builtin_amdgcn_readfirstlane(tid >> 6), lane = tid & 63, l31 = lane & 31, hh = lane >> 5;
    const int b = bh >> 4, h = bh & 15, c0 = 4 * ib, j = w >> 1;
    const size_t mq = (size_t)b * SEQ + 256 * ib + 32 * w + l31;
    LAS float* bt = (LAS float*)(lds + AL_BT);
    for (int i = tid; i < 513; i += 512) bt[i] = T.relb[h * 513 + i] * 1.4426950408889634f;
    bf16x8 qf[8];
#pragma unroll
    for (int ks = 0; ks < 8; ++ks) qf[ks] = *(const GAS bf16x8*)(T.QB + mq * DH + h * HD + 16 * ks + 8 * hh);
    f32x16 O[4];
#pragma unroll
    for (int d = 0; d < 4; ++d)
#pragma unroll
        for (int r = 0; r < 16; ++r) O[d][r] = 0.f;
    float m_run = -1e30f, l_run = 0.f;
    const int tt_lo = (8 - c0) > 0 ? (8 - c0) : 0;
    const int lr = tid >> 4, lc = tid & 15;
    v4u kreg[2], vreg[2];
#define AT_LOAD(tt) do { const size_t mk = (size_t)b * SEQ + (size_t)(64 * (c0 - 8 + (tt))); _Pragma("unroll") for (int i = 0; i < 2; ++i) { const size_t o = (mk + lr + 32 * i) * DH + h * HD + 8 * lc; \
        kreg[i] = *(const GAS v4u*)(T.KB + o); vreg[i] = *(const GAS v4u*)(T.VB + o); } } while (0)
#define AT_STORE(buf) do { _Pragma("unroll") for (int i = 0; i < 2; ++i) { const int o = (buf) * A_TILE + (lr + 32 * i) * A_RS + lc * 16; \
        *(LAS v4u*)(lds + AL_K + o) = kreg[i]; *(LAS v4u*)(lds + AL_V + o) = vreg[i]; } } while (0)
    AT_LOAD(tt_lo); AT_STORE(tt_lo & 1);
    __syncthreads();
    for (int tt = tt_lo; tt < 12; ++tt) {
        if (tt + 1 < 12) AT_LOAD(tt + 1);
        if (j <= tt && tt <= j + 8) {
            const int dist = j + 8 - tt;
            const LAS unsigned char* Kt = lds + AL_K + (tt & 1) * A_TILE; const LAS unsigned char* Vt = lds + AL_V + (tt & 1) * A_TILE;
            f32x16 s0, s1;
#pragma unroll
            for (int r = 0; r < 16; ++r) { s0[r] = 0.f; s1[r] = 0.f; }
#pragma unroll
            for (int ks = 0; ks < 8; ++ks) {
                const bf16x8 a0 = *(const LAS bf16x8*)(Kt + l31 * A_RS + (16 * ks + 8 * hh) * 2);
                const bf16x8 a1 = *(const LAS bf16x8*)(Kt + (32 + l31) * A_RS + (16 * ks + 8 * hh) * 2);
                s0 = __builtin_amdgcn_mfma_f32_32x32x16_bf16(a0, qf[ks], s0, 0, 0, 0);
                s1 = __builtin_amdgcn_mfma_f32_32x32x16_bf16(a1, qf[ks], s1, 0, 0, 0);
            }
            const int qi = 32 * (w & 1) + l31; const int relb0 = 64 * dist + qi - 4 * hh;
            float mx = -1e30f;
#pragma unroll
            for (int r = 0; r < 16; ++r) { const int ki = 8 * (r >> 2) + (r & 3); int i0 = relb0 - ki; int i1 = i0 - 32; i0 = (i0 > 256 ? 256 : i0) + 256; i1 = (i1 > 256 ? 256 : i1) + 256;
                s0[r] += bt[i0]; s1[r] += bt[i1]; mx = fmaxf(mx, fmaxf(s0[r], s1[r])); }
            mx = fmaxf(mx, __shfl_xor(mx, 32));
            const float m_new = fmaxf(m_run, mx); const float alpha = __builtin_amdgcn_exp2f(m_run - m_new); m_run = m_new;
            float ps = 0.f;
#pragma unroll
            for (int r = 0; r < 16; ++r) { s0[r] = __builtin_amdgcn_exp2f(s0[r] - m_new); s1[r] = __builtin_amdgcn_exp2f(s1[r] - m_new); ps += s0[r] + s1[r]; }
            l_run = l_run * alpha + ps;
#pragma unroll
            for (int d = 0; d < 4; ++d)
#pragma unroll
                for (int r = 0; r < 16; ++r) O[d][r] *= alpha;
            const int g = lane >> 4, tq = (lane & 15) >> 2, tp = lane & 3;
            const LAS unsigned char* vbase = Vt + (4 * hh + tq) * A_RS + (16 * (g & 1) + 4 * tp) * 2;
#pragma unroll
            for (int blk = 0; blk < 2; ++blk)
#pragma unroll
                for (int s = 0; s < 2; ++s) {
                    const bf16x8 pb = blk == 0 ? pack8(s0[8 * s + 0], s0[8 * s + 1], s0[8 * s + 2], s0[8 * s + 3], s0[8 * s + 4], s0[8 * s + 5], s0[8 * s + 6], s0[8 * s + 7])
                                               : pack8(s1[8 * s + 0], s1[8 * s + 1], s1[8 * s + 2], s1[8 * s + 3], s1[8 * s + 4], s1[8 * s + 5], s1[8 * s + 6], s1[8 * s + 7]);
#pragma unroll
                    for (int d = 0; d < 4; ++d) {
                        const LAS unsigned char* p = vbase + (32 * blk + 16 * s) * A_RS + 64 * d;
                        const s16x4 lo = vtr(p), hi = vtr(p + 8 * A_RS);
                        const bf16x8 va = (bf16x8){lo[0], lo[1], lo[2], lo[3], hi[0], hi[1], hi[2], hi[3]};
                        O[d] = __builtin_amdgcn_mfma_f32_32x32x16_bf16(va, pb, O[d], 0, 0, 0);
                    }
                }
        }
        if (tt + 1 < 12) AT_STORE((tt + 1) & 1);
        __syncthreads();
    }
#undef AT_LOAD
#undef AT_STORE
    const float lt = l_run + __shfl_xor(l_run, 32); const float inv = 1.0f / lt;
#pragma unroll
    for (int d = 0; d < 4; ++d)
#pragma unroll
        for (int rq = 0; rq < 4; ++rq) { v2u o; o.x = pk2(O[d][4 * rq] * inv, O[d][4 * rq + 1] * inv); o.y = pk2(O[d][4 * rq + 2] * inv, O[d][4 * rq + 3] * inv);
            *(GAS v2u*)(T.YB + mq * D + h * HD + 32 * d + 8 * rq + 4 * hh) = o; }
}

constexpr int H2_RS = 272, H2_ARR = 64 * H2_RS;
constexpr int H2_Q2 = 0, H2_QM = H2_ARR, H2_KM = 2 * H2_ARR, H2_KE = 3 * H2_ARR, H2_V = 4 * H2_ARR;
constexpr int H2_SB = 5 * H2_ARR;
constexpr int H2_TOT = H2_SB + 128 * H2_RS, H2_D = H2_TOT + 8 * 128 * 4, H2_SS = H2_D + 512, H2_END = H2_SS + 4 * 64 * 4;
static_assert(H2_END <= RING_BYTES, "HGRN2 LDS map");
template <bool OUT> __device__ __forceinline__ void hgrn2_item(const HgT& T, LAS unsigned char* lds, int bh, int seg, int tid) {
    const int w = __builtin_amdgcn_readfirstlane(tid >> 6), lane = tid & 63, l31 = lane & 31, hh = lane >> 5;
    const int tb = w & 1, vb = w >> 1, kp = lane;
    const int b = bh >> 4, h = bh & 15, c0 = h * HD;
    const size_t m0 = (size_t)b * SEQ + (size_t)seg * HG_SEGLEN;
    const int it0 = bh * HG_NSEG + seg;
    LAS float* tot = (LAS float*)(lds + H2_TOT); LAS float* dvec = (LAS float*)(lds + H2_D); LAS float* ssq = (LAS float*)(lds + H2_SS);
    const int g = lane >> 4, tq = (lane & 15) >> 2, tp = lane & 3;
    const int tr_off = tq * H2_RS + (16 * (g & 1) + 4 * tp) * 2;
    f32x16 S[2];
#pragma unroll
    for (int i = 0; i < 2; ++i)
#pragma unroll
        for (int r = 0; r < 16; ++r) S[i][r] = 0.f;
    if (OUT) {
        for (int j = 0; j < seg; ++j) { const int itj = bh * HG_NSEG + j;
#pragma unroll
            for (int i = 0; i < 2; ++i) { const int kb = 2 * (w & 1) + i;
#pragma unroll
                for (int rq = 0; rq < 4; ++rq) { const int k0 = 32 * kb + 8 * rq + 4 * hh; const f32x4 dj = *(const GAS f32x4*)(T.DSEG + itj * 128 + k0);
#pragma unroll
                    for (int e = 0; e < 4; ++e) S[i][4 * rq + e] = dj[e] * S[i][4 * rq + e] + T.SEND[((size_t)itj * 128 + k0 + e) * 128 + 32 * vb + l31]; } } }
#pragma unroll
        for (int i = 0; i < 2; ++i) { const int kb = 2 * (w & 1) + i;
#pragma unroll
            for (int rq = 0; rq < 4; ++rq) { v2u o; o.x = cvtpk_s(S[i][4 * rq], S[i][4 * rq + 1]); o.y = cvtpk_s(S[i][4 * rq + 2], S[i][4 * rq + 3]);
                *(LAS v2u*)(lds + H2_SB + (32 * vb + l31) * H2_RS + (32 * kb + 8 * rq + 4 * hh) * 2) = o; } }
    }
    float dtot0 = 1.f, dtot1 = 1.f;
    f32x2_t fr[8]; unsigned qr[8]; v4u vr[2];
    const int lr = tid >> 4, lc = tid & 15;
#define H2_LOAD(c) do { const size_t mrow_ = m0 + (size_t)(c) * 64; \
        _Pragma("unroll") for (int i = 0; i < 8; ++i) { const size_t o_ = (mrow_ + 8 * w + i) * DH + c0 + 2 * kp; fr[i] = *(const GAS f32x2_t*)(T.F + o_); if (OUT) qr[i] = *(const GAS unsigned*)(T.QA + o_); } \
        _Pragma("unroll") for (int i = 0; i < 2; ++i) vr[i] = *(const GAS v4u*)(T.IA + (mrow_ + lr + 32 * i) * DH + c0 + 8 * lc); } while (0)
    H2_LOAD(0);
    for (int c = 0; c < HG_SEGLEN / 64; ++c) {
        const size_t mrow = m0 + (size_t)c * 64;
        float pre0[8], pre1[8], suf0[8], suf1[8];
        { float a0 = 1.f, a1 = 1.f;
#pragma unroll
          for (int i = 0; i < 8; ++i) { a0 *= fr[i].x; a1 *= fr[i].y; pre0[i] = a0; pre1[i] = a1; }
          float s0 = 1.f, s1 = 1.f;
#pragma unroll
          for (int i = 7; i >= 0; --i) { suf0[i] = s0; suf1[i] = s1; s0 *= fr[i].x; s1 *= fr[i].y; } }
        *(LAS f32x2_t*)(tot + w * 128 + 2 * kp) = (f32x2_t){pre0[7], pre1[7]};
        __syncthreads();
        float ps0 = 1.f, ps1 = 1.f, pe0 = 1.f, pe1 = 1.f, pm0 = 1.f, pm1 = 1.f, pa0 = 1.f, pa1 = 1.f;
#pragma unroll
        for (int j = 0; j < 8; ++j) { const f32x2_t tj = *(const LAS f32x2_t*)(tot + j * 128 + 2 * kp);
            pa0 *= tj.x; pa1 *= tj.y;
            const bool cs = j < w, ce = j > w, cm = (w <= 3) ? (j > w && j <= 3) : (j >= 4 && j < w);
            ps0 *= cs ? tj.x : 1.0f; ps1 *= cs ? tj.y : 1.0f; pe0 *= ce ? tj.x : 1.0f; pe1 *= ce ? tj.y : 1.0f; pm0 *= cm ? tj.x : 1.0f; pm1 *= cm ? tj.y : 1.0f; }
        if (w == 0) { *(LAS f32x2_t*)(dvec + 2 * kp) = (f32x2_t){pa0, pa1}; dtot0 *= pa0; dtot1 *= pa1; }
#pragma unroll
        for (int i = 0; i < 8; ++i) {
            const int t = 8 * w + i;
            const float k0 = 1.0f - fr[i].x, k1 = 1.0f - fr[i].y;
            const float ee0 = suf0[i] * pe0, ee1 = suf1[i] * pe1;
            *(LAS unsigned*)(lds + H2_KE + t * H2_RS + 4 * kp) = cvtpk_s(k0 * ee0, k1 * ee1);
            if (OUT) {
                const float q0 = bflo(qr[i]), q1 = bfhi(qr[i]);
                const float es0 = ps0 * pre0[i], es1 = ps1 * pre1[i];
                float em0, em1, ei0, ei1;
                if (w <= 3) { ei0 = fmaxf(suf0[i] * pm0, 1e-30f); ei1 = fmaxf(suf1[i] * pm1, 1e-30f); em0 = __builtin_amdgcn_rcpf(ei0); em1 = __builtin_amdgcn_rcpf(ei1); }
                else        { em0 = fmaxf(pm0 * pre0[i], 1e-30f); em1 = fmaxf(pm1 * pre1[i], 1e-30f); ei0 = __builtin_amdgcn_rcpf(em0); ei1 = __builtin_amdgcn_rcpf(em1); }
                *(LAS unsigned*)(lds + H2_Q2 + t * H2_RS + 4 * kp) = cvtpk_s(q0 * es0, q1 * es1);
                *(LAS unsigned*)(lds + H2_QM + t * H2_RS + 4 * kp) = cvtpk_s(q0 * em0, q1 * em1);
                *(LAS unsigned*)(lds + H2_KM + t * H2_RS + 4 * kp) = cvtpk_s(k0 * ei0, k1 * ei1);
            }
        }
#pragma unroll
        for (int i = 0; i < 2; ++i) *(LAS v4u*)(lds + H2_V + (lr + 32 * i) * H2_RS + lc * 16) = vr[i];
        __syncthreads();
        if (c + 1 < HG_SEGLEN / 64) H2_LOAD(c + 1);
        v2u gq[4];
        if (OUT) {
#pragma unroll
            for (int rq = 0; rq < 4; ++rq) gq[rq] = *(const GAS v2u*)(T.GA + (mrow + 32 * tb + l31) * DH + c0 + 32 * vb + 8 * rq + 4 * hh);
        }
#pragma unroll
        for (int i = 0; i < 2; ++i) { const int kb = 2 * (w & 1) + i;
#pragma unroll
            for (int rq = 0; rq < 4; ++rq) { const f32x4 d4 = *(const LAS f32x4*)(dvec + 32 * kb + 8 * rq + 4 * hh);
#pragma unroll
                for (int e = 0; e < 4; ++e) S[i][4 * rq + e] *= d4[e]; } }
#pragma unroll
        for (int st = 0; st < 4; ++st) {
            const LAS unsigned char* pv = lds + H2_V + (16 * st + 8 * hh) * H2_RS + (32 * vb) * 2 + tr_off;
            const s16x4 v_lo = vtr(pv), v_hi = vtr(pv + 4 * H2_RS);
            const bf16x8 vfr = (bf16x8){v_lo[0], v_lo[1], v_lo[2], v_lo[3], v_hi[0], v_hi[1], v_hi[2], v_hi[3]};
#pragma unroll
            for (int i = 0; i < 2; ++i) { const int kb = 2 * (w & 1) + i;
                const LAS unsigned char* pk = lds + H2_KE + (16 * st + 8 * hh) * H2_RS + (32 * kb) * 2 + tr_off;
                const s16x4 k_lo = vtr(pk), k_hi = vtr(pk + 4 * H2_RS);
                const bf16x8 kfr = (bf16x8){k_lo[0], k_lo[1], k_lo[2], k_lo[3], k_hi[0], k_hi[1], k_hi[2], k_hi[3]};
                S[i] = __builtin_amdgcn_mfma_f32_32x32x16_bf16(kfr, vfr, S[i], 0, 0, 0); }
        }
        f32x16 oT;
        if (OUT) {
            f32x16 PT[2];
#pragma unroll
            for (int sb = 0; sb < 2; ++sb)
#pragma unroll
                for (int r = 0; r < 16; ++r) PT[sb][r] = 0.f;
#pragma unroll
            for (int ks = 0; ks < 8; ++ks) {
                const bf16x8 qb = *(const LAS bf16x8*)(lds + H2_QM + (32 * tb + l31) * H2_RS + 32 * ks + 16 * hh);
                const bf16x8 ka = *(const LAS bf16x8*)(lds + H2_KM + l31 * H2_RS + 32 * ks + 16 * hh);
                PT[0] = __builtin_amdgcn_mfma_f32_32x32x16_bf16(ka, qb, PT[0], 0, 0, 0);
                if (tb == 1) { const bf16x8 kb1 = *(const LAS bf16x8*)(lds + H2_KM + (32 + l31) * H2_RS + 32 * ks + 16 * hh);
                    PT[1] = __builtin_amdgcn_mfma_f32_32x32x16_bf16(kb1, qb, PT[1], 0, 0, 0); }
            }
#pragma unroll
            for (int r = 0; r < 16; ++r) { const int sl = 8 * (r >> 2) + 4 * hh + (r & 3); const bool drop = sl > l31;
                PT[0][r] = (drop && tb == 0) ? 0.f : PT[0][r]; PT[1][r] = (drop && tb == 1) ? 0.f : PT[1][r]; }
#pragma unroll
            for (int r = 0; r < 16; ++r) oT[r] = 0.f;
#pragma unroll
            for (int ks = 0; ks < 8; ++ks) {
                const bf16x8 sa = *(const LAS bf16x8*)(lds + H2_SB + (32 * vb + l31) * H2_RS + 32 * ks + 16 * hh);
                const bf16x8 qb = *(const LAS bf16x8*)(lds + H2_Q2 + (32 * tb + l31) * H2_RS + 32 * ks + 16 * hh);
                oT = __builtin_amdgcn_mfma_f32_32x32x16_bf16(sa, qb, oT, 0, 0, 0);
            }
#pragma unroll
            for (int sb = 0; sb < 2; ++sb) {
                if (sb <= tb) {
#pragma unroll
                    for (int s2 = 0; s2 < 2; ++s2) {
                        const bf16x8 pb = pack8(PT[sb][8 * s2 + 0], PT[sb][8 * s2 + 1], PT[sb][8 * s2 + 2], PT[sb][8 * s2 + 3], PT[sb][8 * s2 + 4], PT[sb][8 * s2 + 5], PT[sb][8 * s2 + 6], PT[sb][8 * s2 + 7]);
                        const LAS unsigned char* pv = lds + H2_V + (32 * sb + 16 * s2 + 4 * hh) * H2_RS + (32 * vb) * 2 + tr_off;
                        const s16x4 lo = vtr(pv), hi = vtr(pv + 8 * H2_RS);
                        const bf16x8 va = (bf16x8){lo[0], lo[1], lo[2], lo[3], hi[0], hi[1], hi[2], hi[3]};
                        oT = __builtin_amdgcn_mfma_f32_32x32x16_bf16(va, pb, oT, 0, 0, 0);
                    }
                }
            }
            float ss = 0.f;
#pragma unroll
            for (int r = 0; r < 16; ++r) ss += oT[r] * oT[r];
            ss += __shfl_xor(ss, 32);
            if (hh == 0) ssq[vb * 64 + 32 * tb + l31] = ss;
        }
        __syncthreads();
        if (OUT) {
            const int t = 32 * tb + l31;
            const float tot2 = (ssq[t] + ssq[64 + t]) + (ssq[128 + t] + ssq[192 + t]);
            const float rn = 1.0f / sqrtf(tot2 * (1.f / HD) + NORM_EPS);
#pragma unroll
            for (int rq = 0; rq < 4; ++rq) { v2u o; const f32x4 n4 = *(const GAS f32x4*)(T.normg + c0 + 32 * vb + 8 * rq + 4 * hh);
                o.x = pk2(oT[4 * rq] * rn * n4[0] * bflo(gq[rq].x), oT[4 * rq + 1] * rn * n4[1] * bfhi(gq[rq].x));
                o.y = pk2(oT[4 * rq + 2] * rn * n4[2] * bflo(gq[rq].y), oT[4 * rq + 3] * rn * n4[3] * bfhi(gq[rq].y));
                *(GAS v2u*)(T.YA + (mrow + t) * D + c0 + 32 * vb + 8 * rq + 4 * hh) = o; }
#pragma unroll
            for (int i = 0; i < 2; ++i) { const int kb = 2 * (w & 1) + i;
#pragma unroll
                for (int rq = 0; rq < 4; ++rq) { v2u o; o.x = cvtpk_s(S[i][4 * rq], S[i][4 * rq + 1]); o.y = cvtpk_s(S[i][4 * rq + 2], S[i][4 * rq + 3]);
                    *(LAS v2u*)(lds + H2_SB + (32 * vb + l31) * H2_RS + (32 * kb + 8 * rq + 4 * hh) * 2) = o; } }
        }
    }
#undef H2_LOAD
    if (!OUT) {
#pragma unroll
        for (int i = 0; i < 2; ++i) { const int kb = 2 * (w & 1) + i;
#pragma unroll
            for (int r = 0; r < 16; ++r) T.SEND[((size_t)it0 * 128 + 32 * kb + 8 * (r >> 2) + 4 * hh + (r & 3)) * 128 + 32 * vb + l31] = S[i][r]; }
        if (w == 0) *(GAS f32x2_t*)(T.DSEG + it0 * 128 + 2 * kp) = (f32x2_t){dtot0, dtot1};
    }
    __syncthreads();
}

struct Args { const float* in[21]; float* out; unsigned char* ws; int ph_lo, ph_hi, li, pad; };
__global__ void __launch_bounds__(NWAVES * 64, 2) mk_fwd(Args args) {
    extern __shared__ __attribute__((aligned(16))) unsigned char lds_raw[];
    LAS unsigned char* lds = (LAS unsigned char*)lds_raw;
    volatile LAS unsigned* MISC = (volatile LAS unsigned*)(lds + MISC_OFF);
    const int wave = __builtin_amdgcn_readfirstlane(threadIdx.x >> 6);
#define TID_HERE() const int lane = lane_now(), tid = wave * 64 + lane; (void)tid; (void)lane
    const int G = gridDim.x;
    unsigned char* ws = args.ws;
    gu32* ctl = (gu32*)(ws + WS_CTL);
    { TID_HERE(); for (int u = tid; u < (LDS_BYTES - LDSCTL_OFF) / 4; u += NWAVES * 64) ((LAS unsigned*)(lds + LDSCTL_OFF))[u] = 0u; }
    __syncthreads();
    XcdBarrier bar; bar.bar = (unsigned*)(ctl + CW_BAR); bar.x = 0; bar.st = nullptr; bar.w0 = (wave == 0);
    if (MK_N_LAUNCHES == 1) bar = xcd_barrier_post((unsigned*)(ctl + CW_BAR), MISC + 8, wave == 0);
#define GRID_BAR() do { if (MK_N_LAUNCHES == 1) xcd_barrier(bar); } while (0)
    const int lo = args.ph_lo, hi = args.ph_hi;
#define IN(k) (lo <= (k) && (k) < hi)
#define BOTH(k) (IN(k) && IN((k) + 1))
    const float* x = args.in[0]; float* out = args.out;
    bf16* W13_1 = (bf16*)(ws + WS_W13_1); bf16* W2_1 = (bf16*)(ws + WS_W2_1); bf16* W13_2 = (bf16*)(ws + WS_W13_2); bf16* W2_2 = (bf16*)(ws + WS_W2_2);
    bf16* WIN = (bf16*)(ws + WS_WIN); bf16* WUAB = (bf16*)(ws + WS_WUA); bf16* WO = (bf16*)(ws + WS_WO);
    bf16* XN = (bf16*)(ws + WS_XN); bf16* Y = (bf16*)(ws + WS_Y); bf16* HID = (bf16*)(ws + WS_HID);
    float* LB = (float*)(ws + WS_LB);
    bf16* X1B = (bf16*)(ws + WS_W13_1);
    unsigned char* XQG = ws + WS_W2_1;
    unsigned char* XQF = (unsigned char*)(ws + WS_XN);
    unsigned char* WGQ = ws + WS_WIN + (size_t)NPROJ * D * 2;
    unsigned char* W13Q_1 = ws + WS_W13_1; unsigned char* W13Q_2 = ws + WS_W13_2;
    float* CM1 = (float*)(ws + WS_CM1); float* CM2 = (float*)(ws + WS_CM2); float* CMG = (float*)(ws + WS_CMG);
    float* SA1 = (float*)(ws + WS_SA1); float* SA2 = (float*)(ws + WS_SA2); float* SAG = (float*)(ws + WS_SAG);
    unsigned* CMD1 = (unsigned*)(ws + WS_CMD1); unsigned* CMD2 = (unsigned*)(ws + WS_CMD2); float* SAH = (float*)(ws + WS_SAH);
    float* CMD1f = (float*)(ws + WS_CMD1); float* CMD2f = (float*)(ws + WS_CMD2);
    bf16* W2R_1 = (bf16*)(ws + WS_HQ); bf16* W2R_2 = (bf16*)(ws + WS_W2R2);
    unsigned char* HQ = ws + WS_HQ;
    bf16* XB = (bf16*)(ws + WS_Y + 128 * MiB);
    unsigned char* W2Q_1 = ws + WS_W2_1; unsigned char* W2Q_2 = ws + WS_W2_2;
    bf16* X2B = (bf16*)(ws + WS_WIN);
    const int gw = blockIdx.x * NWAVES + wave, NGW = G * NWAVES;

    if (IN(0)) {
        TID_HERE();
        LAS float* scr = (LAS float*)(lds + RING_OFF + wave * 16384);
        constexpr int I_2 = (DFF / 64) * (D / 32), I_IN = (D / 64) * (NPROJ / 32), I_U = (DH / 64) * (D / 32), I_O = (D / 64) * (D / 32);
        constexpr int Q_G = DFF / 32, Q_8 = NGATE / 32;
        if constexpr ((DQ1 || DQ2) && !W2ROT) {
            if constexpr (DQ2) { constexpr int nb0 = TAILW2 ? TAILNB : 0, nbn = D / 32 - nb0; for (int it = gw; it < (DFF / 64) * nbn; it += NGW) w2_had_item<false>(args.in[20], nullptr, CMD2, it, scr, lane, nb0, nbn); }
            if constexpr (DQ1) for (int it = gw; it < I_2; it += NGW) w2_had_item<false>(args.in[5], nullptr, CMD1, it, scr, lane);
            GRID_BAR();
            if constexpr (DQ1) for (int it = gw; it < I_2; it += NGW) w2_had_item<true>(args.in[5], W2Q_1, CMD1, it, scr, lane);
        }
        __syncthreads();
        for (int it = blockIdx.x; it < 4 * Q_G + Q_8; it += G) {
            if (it < 4 * Q_G) { const int mat = it / Q_G, n0 = 32 * (it % Q_G);
                const float* W = mat == 0 ? args.in[3] : mat == 1 ? args.in[4] : mat == 2 ? args.in[18] : args.in[19];
                wg_q8_item_h(W, DFF, n0, mat < 2 ? W13Q_1 : W13Q_2, 256 * (n0 >> 7) + (n0 & 127) + 128 * (mat & 1), mat < 2 ? CM1 : CM2, lds, wave, lane); }
            else { const int d0 = 32 * (it - 4 * Q_G); wg_q8_item_h(args.in[8], NIN, win_src_q8(d0), WGQ, d0, CMG, lds, wave, lane); }
        }
        {
            constexpr int NA = 2 * I_2 + I_IN + 2 * I_U + I_O;
            for (int it = gw; it < NA; it += NGW) {
                int r = it;
                if (r < I_2) { if constexpr (W2ROT) w2_rot_item(args.in[5], W2R_1, r, scr, lane); else if constexpr (!DQ1) tr_plain(args.in[5], DFF, D, W2_1, r, scr, lane); continue; } r -= I_2;
                if (r < I_2) { if constexpr (W2ROT) w2_rot_item(args.in[20], W2R_2, r, scr, lane); else if constexpr (DQ2) { constexpr int nb0 = TAILW2 ? TAILNB : 0, nbn = D / 32 - nb0; if (r < (DFF / 64) * nbn) w2_had_item<true>(args.in[20], W2Q_2, CMD2, r, scr, lane, nb0, nbn); } else tr_plain(args.in[20], DFF, D, W2_2, r, scr, lane); continue; } r -= I_2;
                if (r < I_IN) { const int kb = r / (NPROJ / 32), nb = r % (NPROJ / 32); tr_item(args.in[8], D, NIN, WIN, 64 * kb, win_src_bf(32 * nb), 32 * nb, scr, lane); continue; } r -= I_IN;
                if (r < I_U) { const int kb = r / (D / 32), nb = r % (D / 32); tr_item(args.in[13], D, D, WUAB, 64 * kb, 32 * nb, 32 * nb, scr, lane, 64 * kb); continue; } r -= I_U;
                if (r < I_U) { const int kb = r / (D / 32), nb = r % (D / 32); tr_item(args.in[14], D, D, WUAB, 64 * kb, 32 * nb, 32 * nb, scr, lane, DH + 64 * kb); continue; } r -= I_U;
                tr_plain(args.in[15], D, D, WO, r, scr, lane);
            }
            if (blockIdx.x == 0) { for (int i = tid; i < DH; i += NWAVES * 64) { const float l0 = args.in[10][i], l1 = args.in[10][DH + i]; LB[i] = 1.0f / (1.0f + __expf(l1 - l0)); } }
            for (int m = gw; m < M; m += NGW) rms_row_to_q8(x + (size_t)m * D, args.in[1], XQF + (size_t)m * D, SA1 + m, lane, XB + (size_t)m * D);
        }
        if (BOTH(0)) GRID_BAR();
    }
    if (IN(1)) {
        pg8::Gemm g{(const bf16*)XQF, (const bf16*)W13Q_1, M, NUP, D / 2}; pg8::StaticOrder S; S.init(M, NUP, G, (int)blockIdx.x); S.wv = wave;
        pg8::EpiSwigluQ8T<DQ1> E{HID, DFF, SA1, CM1};
        pg8::gemm_phase<pg8::EpiSwigluQ8T<DQ1>, pg8::StaticOrder, true, true, true>(lds + RING_OFF, g, S, E);
        if constexpr (W2ROT) {
            const int nun = (M / 256) * (NUP / 256), tailc = nun % G, base = tailc ? tailc : 0, NI = G - base;
            if ((int)blockIdx.x >= base) { TID_HERE();
                for (int n = ((int)blockIdx.x - base) * NWAVES + wave; n < D; n += NI * NWAVES) hid_row_to_q8(W2R_1 + (size_t)n * DFF, W2Q_1 + (size_t)n * DFF, CMD1f + n, lane); } }
        if constexpr (TAILW2) {
            const int nun = (M / 256) * (NUP / 256), tailc = nun % G, base = tailc ? tailc : 0, NI = G - base;
            if ((int)blockIdx.x >= base) { TID_HERE(); LAS float* scr = (LAS float*)(lds + RING_OFF + wave * 16384);
                w2_had_stream<false>(args.in[20], nullptr, CMD2, ((int)blockIdx.x - base) * NWAVES + wave, NI * NWAVES, (DFF / 64) * TAILNB, scr, lane, TAILNB); } }
        if (BOTH(1)) GRID_BAR();
        if constexpr (DQ1) { TID_HERE(); for (int m = gw; m < M; m += NGW) hid_row_to_q8(HID + (size_t)m * DFF, HQ + (size_t)m * DFF, SAH + m, lane); GRID_BAR(); }
    }
    if (IN(2)) {
        if constexpr (DQ1) { pg8::Gemm g{(const bf16*)HQ, (const bf16*)W2Q_1, M, D, DFF / 2}; pg8::StaticOrder S; S.init(M, D, G, (int)blockIdx.x); S.wv = wave;
            pg8::EpiBf16Q8 E{Y, D, SAH, CMD1f, 1.0f / 32.0f};
            pg8::gemm_phase<pg8::EpiBf16Q8, pg8::StaticOrder, true, true, true>(lds + RING_OFF, g, S, E); }
        else { pg8::Gemm g{HID, W2_1, M, D, DFF}; pg8::StaticOrder S; S.init(M, D, G, (int)blockIdx.x); S.wv = wave;
            pg8::EpiBf16Plain E{Y, D};
            pg8::gemm_phase<pg8::EpiBf16Plain, pg8::StaticOrder, true, true>(lds + RING_OFF, g, S, E); }
        if (BOTH(2)) GRID_BAR();
    }
    if (IN(3)) {
        TID_HERE();
        for (int m = gw; m < M; m += NGW) post_row<true, true, true, true, true>(Y + (size_t)m * D, XB + (size_t)m * D, X1B + (size_t)m * D, args.in[2], 0.5f, args.in[6], XN + (size_t)m * D, lane, XQG + (size_t)m * D, SAG + m);
        if (BOTH(3)) GRID_BAR();
    }
    if (IN(4)) {
        { pg8::Gemm g{(const bf16*)XQG, (const bf16*)WGQ, M, NGATE, D / 2}; pg8::StaticOrder S; S.init(M, NGATE, G, (int)blockIdx.x); S.wv = wave;
          pg8::EpiGatesQ8 E{(bf16*)(ws + WS_GTA), (bf16*)(ws + WS_GTB), (float*)(ws + WS_F), LB, args.in[9], SAG, CMG,
                            (bf16*)(ws + WS_QA), (bf16*)(ws + WS_IA), (bf16*)(ws + WS_GA), (bf16*)(ws + WS_QB), (bf16*)(ws + WS_KB), (bf16*)(ws + WS_VB), 0.08838834764831845f * 1.4426950408889634f};
          pg8::gemm_phase<pg8::EpiGatesQ8, pg8::StaticOrder, true, true, true>(lds + RING_OFF, g, S, E); }
        { pg8::Gemm g{XN, WIN, M, NPROJ, D}; pg8::StaticOrder S; S.init(M, NPROJ, G, (int)blockIdx.x); S.wv = wave;
          pg8::EpiProj E{(bf16*)(ws + WS_QA), (bf16*)(ws + WS_IA), (bf16*)(ws + WS_GA), (bf16*)(ws + WS_QB), (bf16*)(ws + WS_KB), (bf16*)(ws + WS_VB),
                         0.08838834764831845f * 1.4426950408889634f};
          pg8::gemm_phase<pg8::EpiProj, pg8::StaticOrder, true, true>(lds + RING_OFF, g, S, E); }
        if (BOTH(4)) GRID_BAR();
    }
    const HgT HT{(const float*)(ws + WS_F), (const bf16*)(ws + WS_QA), (const bf16*)(ws + WS_IA), (const bf16*)(ws + WS_GA), args.in[11], (float*)(ws + WS_SEND), (float*)(ws + WS_DSEG), (bf16*)(ws + WS_YAB)};
    if (IN(5)) {
        TID_HERE();
        for (int it = blockIdx.x; it < 32 * HG_NSEG; it += G) { const int bh = it >> 3, seg = it & 7; if (seg < HG_NSEG - 1) hgrn2_item<false>(HT, lds, bh, seg, tid); }
        const AtT AT{(const bf16*)(ws + WS_QB), (const bf16*)(ws + WS_KB), (const bf16*)(ws + WS_VB), args.in[12], (bf16*)(ws + WS_YAB) + DH};
        for (int it = blockIdx.x; it < 1024; it += G) attn_item(AT, lds, it & 31, it >> 5, tid);
        if (BOTH(5)) GRID_BAR();
    }
    if (IN(6)) {
        TID_HERE();
        for (int it = blockIdx.x; it < 32 * HG_NSEG; it += G) hgrn2_item<true>(HT, lds, it >> 3, it & 7, tid);
        if (BOTH(6)) GRID_BAR();
    }
    if (IN(7)) {
        pg8::Gemm g{(const bf16*)(ws + WS_YAB), WUAB, M, D, D}; pg8::StaticOrder S; S.init(M, D, G, (int)blockIdx.x); S.wv = wave;
        pg8::EpiUpGate E{(bf16*)(ws + WS_MX), (const unsigned char*)(ws + WS_GTA), (const unsigned char*)(ws + WS_GTB)};
        pg8::gemm_phase<pg8::EpiUpGate, pg8::StaticOrder, true, true>(lds + RING_OFF, g, S, E);
        if (BOTH(7)) GRID_BAR();
    }
    if (IN(9)) {
        pg8::Gemm g{(const bf16*)(ws + WS_MX), WO, M, D, D}; pg8::StaticOrder S; S.init(M, D, G, (int)blockIdx.x); S.wv = wave;
        pg8::EpiBf16Plain E{Y, D};
        pg8::gemm_phase<pg8::EpiBf16Plain, pg8::StaticOrder, true, true>(lds + RING_OFF, g, S, E);
        if (BOTH(9)) GRID_BAR();
    }
    if (IN(10)) {
        TID_HERE();
        for (int m = gw; m < M; m += NGW) post_row<true, true, true, false, true>(Y + (size_t)m * D, X1B + (size_t)m * D, X2B + (size_t)m * D, args.in[7], 1.0f, args.in[16], nullptr, lane, XQF + (size_t)m * D, SA2 + m);
        if (BOTH(10)) GRID_BAR();
    }
    if (IN(11)) {
        pg8::Gemm g{(const bf16*)XQF, (const bf16*)W13Q_2, M, NUP, D / 2}; pg8::StaticOrder S; S.init(M, NUP, G, (int)blockIdx.x); S.wv = wave;
        pg8::EpiSwigluQ8T<DQ2> E{HID, DFF, SA2, CM2};
        pg8::gemm_phase<pg8::EpiSwigluQ8T<DQ2>, pg8::StaticOrder, true, true, true>(lds + RING_OFF, g, S, E);
        if constexpr (W2ROT) {
            const int nun = (M / 256) * (NUP / 256), tailc = nun % G, base = tailc ? tailc : 0, NI = G - base;
            if ((int)blockIdx.x >= base) { TID_HERE();
                for (int n = ((int)blockIdx.x - base) * NWAVES + wave; n < D; n += NI * NWAVES) hid_row_to_q8(W2R_2 + (size_t)n * DFF, W2Q_2 + (size_t)n * DFF, CMD2f + n, lane); } }
        if constexpr (TAILW2) {
            const int nun = (M / 256) * (NUP / 256), tailc = nun % G, base = tailc ? tailc : 0, NI = G - base;
            if ((int)blockIdx.x >= base) { TID_HERE(); LAS float* scr = (LAS float*)(lds + RING_OFF + wave * 16384);
                w2_had_stream<true>(args.in[20], W2Q_2, CMD2, ((int)blockIdx.x - base) * NWAVES + wave, NI * NWAVES, (DFF / 64) * TAILNB, scr, lane, TAILNB); } }
        if (BOTH(11)) GRID_BAR();
        if constexpr (DQ2) { TID_HERE(); for (int m = gw; m < M; m += NGW) hid_row_to_q8(HID + (size_t)m * DFF, HQ + (size_t)m * DFF, SAH + m, lane); GRID_BAR(); }
    }
    if (IN(12)) {
        if constexpr (DQ2) { pg8::Gemm g{(const bf16*)HQ, (const bf16*)W2Q_2, M, D, DFF / 2}; pg8::StaticOrder S; S.init(M, D, G, (int)blockIdx.x); S.wv = wave;
            pg8::EpiBf16Q8 E{Y, D, SAH, CMD2f, 1.0f / 32.0f};
            pg8::gemm_phase<pg8::EpiBf16Q8, pg8::StaticOrder, true, true, true>(lds + RING_OFF, g, S, E); }
        else { pg8::Gemm g{HID, W2_2, M, D, DFF}; pg8::StaticOrder S; S.init(M, D, G, (int)blockIdx.x); S.wv = wave;
            pg8::EpiBf16Plain E{Y, D};
            pg8::gemm_phase<pg8::EpiBf16Plain, pg8::StaticOrder, true, true>(lds + RING_OFF, g, S, E); }
        if (BOTH(12)) GRID_BAR();
    }
    if (IN(13)) {
        TID_HERE();
        for (int m = gw; m < M; m += NGW) post_row<false, true, false>(Y + (size_t)m * D, X2B + (size_t)m * D, out + (size_t)m * D, args.in[17], 0.5f, nullptr, nullptr, lane);
    }
#undef IN
#undef BOTH
#undef GRID_BAR
}

extern "C" void kernel_launch(void* const* d_in, const int* in_sizes, int n_in, void* d_out, int out_size, void* d_ws, size_t ws_size, hipStream_t stream) {
    static int grid = 0;
    if (grid == 0) {
        if (n_in != 21 || in_sizes[0] != M * D || out_size != M * D || ws_size < WS_END) { fprintf(stderr, "kernel_launch: unexpected shapes: n_in %d, in0 %d, out %d, ws %zu (need %zu); nothing launched\n", n_in, n_in > 0 ? in_sizes[0] : -1, out_size, ws_size, (size_t)WS_END); grid = -1; return; }
        int dev = 0, cus = 0, per_cu = 0;
        if (hipGetDevice(&dev) != hipSuccess || hipDeviceGetAttribute(&cus, hipDeviceAttributeMultiprocessorCount, dev) != hipSuccess) { fprintf(stderr, "kernel_launch: device query failed\n"); grid = -1; return; }
        if (hipFuncSetAttribute((const void*)mk_fwd, hipFuncAttributeMaxDynamicSharedMemorySize, LDS_BYTES) != hipSuccess) { fprintf(stderr, "kernel_launch: hipFuncSetAttribute failed\n"); grid = -1; return; }
        if (hipOccupancyMaxActiveBlocksPerMultiprocessor(&per_cu, (const void*)mk_fwd, NWAVES * 64, LDS_BYTES) != hipSuccess || per_cu < 1)
            fprintf(stderr, "kernel_launch: note: occupancy query reports %d workgroups per CU\n", per_cu);
        (void)hipGetLastError();
        grid = cus;
    }
    if (grid < 0) return;
    if (hipMemsetAsync((char*)d_ws + WS_CTL, 0, CTL_ZERO_BYTES, stream) != hipSuccess) { fprintf(stderr, "kernel_launch: memset failed\n"); return; }
    Args a{};
    for (int i = 0; i < 21; ++i) a.in[i] = (const float*)d_in[i];
    a.out = (float*)d_out; a.ws = (unsigned char*)d_ws;
    for (int li = 0; li < MK_N_LAUNCHES; ++li) {
        if (MK_N_LAUNCHES == 1) { a.ph_lo = 0; a.ph_hi = NPHASE; } else { a.ph_lo = li; a.ph_hi = li + 1; }
        a.li = li;
        hipLaunchKernelGGL(mk_fwd, dim3(grid), dim3(NWAVES * 64), LDS_BYTES, stream, a);
        const hipError_t le = hipPeekAtLastError();
        if (le != hipSuccess) { fprintf(stderr, "kernel_launch: launch %d failed: %s\n", li, hipGetErrorName(le)); break; }
    }
}
```
